# Optimizing an MI355X kernel written in HIP

```python
import math, functools
import jax, jax.numpy as jnp
from jax import lax
import numpy as np

D_MODEL = 1024
BATCH = 4
SEQ = 4096
DEPTH = 2

N_HEADS_A = 8
HEAD_DIM = 64
N_KV_GROUPS = 2
Q_PER_GROUP = N_HEADS_A // N_KV_GROUPS
D_ATTN = N_HEADS_A * HEAD_DIM
D_KV = N_KV_GROUPS * HEAD_DIM
CMP_BLOCK = 32
CMP_STRIDE = 16
CMP_HIDDEN = 256
SLC_BLOCK = 64
N_SELECT = 16
N_LOCAL = 2
WINDOW = 512
Q_CHUNK = 128
ATTN_SCALE = HEAD_DIM ** -0.5
NEG = -1e30
FORCE_SCORE = 1e4
D_RNN = D_MODEL
N_RNN_BLOCKS = 16
RNN_BLOCK = D_RNN // N_RNN_BLOCKS
CONV_WIDTH = 4
LRU_C = 8.0
D_FF = 4 * D_MODEL
EPS = 1e-6

IN_SIZES = (D_ATTN, D_KV, D_KV, D_KV, D_KV, D_KV, D_KV, N_HEADS_A * 3, D_RNN, D_RNN, D_MODEL, D_MODEL)
IN_SPLITS = tuple(int(v) for v in np.cumsum(IN_SIZES)[:-1])
D_IN = int(sum(IN_SIZES))

kernel_name = "hybrid_nsa_rglru_gated_block"


def rms_norm(x, w):
    xf = x.astype(jnp.float32)
    var = jnp.mean(xf * xf, axis=-1, keepdims=True)
    return (xf * lax.rsqrt(var + EPS) * w.astype(jnp.float32)).astype(x.dtype)


def masked_softmax(s, mask):
    s = jnp.where(mask, s.astype(jnp.float32), NEG)
    m = jnp.max(s, axis=-1, keepdims=True)
    e = jnp.where(mask, jnp.exp(s - m), 0.0)
    return e / jnp.maximum(jnp.sum(e, axis=-1, keepdims=True), 1e-20)


def compress_blocks(k, pos, w1, w2):
    B, S = k.shape[0], k.shape[1]
    kb = k.reshape(B, S // CMP_STRIDE, CMP_STRIDE, N_KV_GROUPS, HEAD_DIM)
    blocks = jnp.concatenate([kb[:, :-1], kb[:, 1:]], axis=2) + pos[:, None, :]
    nc = blocks.shape[1]
    flat = blocks.transpose(0, 1, 3, 2, 4).reshape(B, nc, N_KV_GROUPS, CMP_BLOCK * HEAD_DIM)
    c = jax.nn.gelu(flat @ w1) @ w2
    return c.transpose(0, 2, 1, 3)


def nsa_attention(q, k_cmp, v_cmp, k_slc, v_slc, k_win, v_win, gates, pos_k, pos_v, ck_w1, ck_w2, cv_w1, cv_w2):
    B, S = q.shape[0], q.shape[1]
    G, R, dh = N_KV_GROUPS, Q_PER_GROUP, HEAD_DIM
    nb = S // SLC_BLOCK
    nc = S // CMP_STRIDE - 1
    nqb = S // Q_CHUNK
    k_sel = min(N_SELECT, nb)
    r_s = SLC_BLOCK // CMP_STRIDE
    r_c = CMP_BLOCK // CMP_STRIDE
    off = r_s + r_c - 2

    qh = q.reshape(B, S, G, R, dh).transpose(0, 2, 3, 1, 4)
    gh = gates.reshape(B, S, G, R, 3).transpose(0, 2, 3, 1, 4)
    kc = compress_blocks(k_cmp, pos_k, ck_w1, ck_w2)
    vc = compress_blocks(v_cmp, pos_v, cv_w1, cv_w2)
    ks_blk = k_slc.transpose(0, 2, 1, 3).reshape(B, G, nb, SLC_BLOCK, dh)
    vs_blk = v_slc.transpose(0, 2, 1, 3).reshape(B, G, nb, SLC_BLOCK, dh)
    pad_w = ((0, 0), (0, 0), (WINDOW, 0), (0, 0))
    kw_pad = jnp.pad(k_win.transpose(0, 2, 1, 3), pad_w)
    vw_pad = jnp.pad(v_win.transpose(0, 2, 1, 3), pad_w)
    cmp_end = jnp.arange(nc) * CMP_STRIDE + CMP_BLOCK - 1
    blk = jnp.arange(nb)
    gather = jax.vmap(jax.vmap(lambda blocks, ix: blocks[ix]))

    def chunk(qb):
        t0 = qb * Q_CHUNK
        qc = lax.dynamic_slice_in_dim(qh, t0, Q_CHUNK, axis=3)
        gc = lax.dynamic_slice_in_dim(gh, t0, Q_CHUNK, axis=3)
        tpos = t0 + jnp.arange(Q_CHUNK)
        s = jnp.einsum('bgrcd,bgnd->bgrcn', qc, kc) * ATTN_SCALE
        p_cmp = masked_softmax(s, cmp_end[None, :] <= tpos[:, None])
        o_cmp = jnp.einsum('bgrcn,bgnd->bgrcd', p_cmp, vc.astype(jnp.float32))
        ps = jnp.pad(p_cmp.sum(axis=2), ((0, 0), (0, 0), (0, 0), (off, 0)))
        imp = 0.0
        for m in range(r_s):
            for n in range(r_c):
                st = off - m - n
                imp = imp + ps[..., st:st + r_s * (nb - 1) + 1:r_s]
        cur = tpos // SLC_BLOCK
        valid_b = blk[None, :] <= cur[:, None]
        forced = (blk[None, :] == 0) | (blk[None, :] > cur[:, None] - N_LOCAL)
        score = jnp.where(valid_b, jnp.where(forced, FORCE_SCORE, imp), NEG)
        top_s, idx = lax.top_k(score, k_sel)
        sel_ok = top_s > NEG / 2
        ksel = gather(ks_blk, idx).reshape(B, G, Q_CHUNK, k_sel * SLC_BLOCK, dh)
        vsel = gather(vs_blk, idx).reshape(B, G, Q_CHUNK, k_sel * SLC_BLOCK, dh)
        kpos = idx[..., None] * SLC_BLOCK + jnp.arange(SLC_BLOCK)
        m_slc = (sel_ok[..., None] & (kpos <= tpos[:, None, None])).reshape(B, G, 1, Q_CHUNK, k_sel * SLC_BLOCK)
        s = jnp.einsum('bgrcd,bgcnd->bgrcn', qc, ksel) * ATTN_SCALE
        o_slc = jnp.einsum('bgrcn,bgcnd->bgrcd', masked_softmax(s, m_slc), vsel.astype(jnp.float32))
        kw = lax.dynamic_slice_in_dim(kw_pad, t0, Q_CHUNK + WINDOW, axis=2)
        vw = lax.dynamic_slice_in_dim(vw_pad, t0, Q_CHUNK + WINDOW, axis=2)
        kpos_w = t0 - WINDOW + jnp.arange(Q_CHUNK + WINDOW)
        diff = tpos[:, None] - kpos_w[None, :]
        m_win = (diff >= 0) & (diff < WINDOW) & (kpos_w[None, :] >= 0)
        s = jnp.einsum('bgrcd,bgnd->bgrcn', qc, kw) * ATTN_SCALE
        o_win = jnp.einsum('bgrcn,bgnd->bgrcd', masked_softmax(s, m_win), vw.astype(jnp.float32))
        out = gc[..., 0:1] * o_cmp + gc[..., 1:2] * o_slc + gc[..., 2:3] * o_win
        return out.astype(q.dtype)

    res = lax.map(chunk, jnp.arange(nqb))
    return res.transpose(1, 0, 4, 2, 3, 5).reshape(B, S, D_ATTN)


def rg_lru_branch(xr, gate, conv_w, conv_b, w_a, b_a, w_i, b_i, lam):
    B, S = xr.shape[0], xr.shape[1]
    xp = jnp.pad(xr, ((0, 0), (CONV_WIDTH - 1, 0), (0, 0)))
    xc = conv_b
    for i in range(CONV_WIDTH):
        xc = xc + xp[:, i:i + S] * conv_w[i]
    xb = xc.reshape(B, S, N_RNN_BLOCKS, RNN_BLOCK)
    r = jax.nn.sigmoid(jnp.einsum('bshi,hij->bshj', xb, w_a).reshape(B, S, D_RNN) + b_a)
    ig = jax.nn.sigmoid(jnp.einsum('bshi,hij->bshj', xb, w_i).reshape(B, S, D_RNN) + b_i)
    log_a = -LRU_C * r.astype(jnp.float32) * jax.nn.softplus(-lam.astype(jnp.float32))
    a = jnp.exp(log_a)
    bt = jnp.sqrt(-jnp.expm1(2.0 * log_a)) * (ig * xc).astype(jnp.float32)

    def combine(lhs, rhs):
        a1, b1 = lhs
        a2, b2 = rhs
        return a1 * a2, a2 * b1 + b2

    _, h = lax.associative_scan(combine, (a, bt), axis=1)
    return h.astype(xr.dtype) * jax.nn.gelu(gate)


def setup_inputs(seed: int = 0) -> dict:
    key = jax.random.key(seed)
    ks = jax.random.split(key, 24)
    f32 = jnp.float32

    def nrm(k, shape, fan_in):
        return jax.random.normal(k, shape, f32) * (fan_in ** -0.5)

    a_c = jax.random.uniform(ks[17], (DEPTH, D_RNN), f32, 0.9, 0.999)
    s_l = a_c ** (1.0 / LRU_C)
    lam = jnp.log(s_l) - jnp.log1p(-s_l)
    return {
        "x": jax.random.normal(ks[0], (BATCH, SEQ, D_MODEL), f32),
        "norm1_w": 1.0 + 0.02 * jax.random.normal(ks[1], (DEPTH, D_MODEL), f32),
        "w_in": nrm(ks[2], (DEPTH, D_MODEL, D_IN), D_MODEL),
        "cmp_pos_k": 0.1 * jax.random.normal(ks[3], (DEPTH, CMP_BLOCK, HEAD_DIM), f32),
        "cmp_pos_v": 0.1 * jax.random.normal(ks[4], (DEPTH, CMP_BLOCK, HEAD_DIM), f32),
        "cmp_k_w1": nrm(ks[5], (DEPTH, CMP_BLOCK * HEAD_DIM, CMP_HIDDEN), CMP_BLOCK * HEAD_DIM),
        "cmp_k_w2": nrm(ks[6], (DEPTH, CMP_HIDDEN, HEAD_DIM), CMP_HIDDEN),
        "cmp_v_w1": nrm(ks[7], (DEPTH, CMP_BLOCK * HEAD_DIM, CMP_HIDDEN), CMP_BLOCK * HEAD_DIM),
        "cmp_v_w2": nrm(ks[8], (DEPTH, CMP_HIDDEN, HEAD_DIM), CMP_HIDDEN),
        "conv_w": nrm(ks[9], (DEPTH, CONV_WIDTH, D_RNN), CONV_WIDTH),
        "conv_b": 0.01 * jax.random.normal(ks[10], (DEPTH, D_RNN), f32),
        "lru_w_a": nrm(ks[11], (DEPTH, N_RNN_BLOCKS, RNN_BLOCK, RNN_BLOCK), RNN_BLOCK),
        "lru_b_a": 0.01 * jax.random.normal(ks[12], (DEPTH, D_RNN), f32),
        "lru_w_i": nrm(ks[13], (DEPTH, N_RNN_BLOCKS, RNN_BLOCK, RNN_BLOCK), RNN_BLOCK),
        "lru_b_i": 0.01 * jax.random.normal(ks[14], (DEPTH, D_RNN), f32),
        "lru_lambda": lam,
        "w_up_attn": nrm(ks[15], (DEPTH, D_ATTN, D_MODEL), D_ATTN),
        "w_up_rnn": nrm(ks[16], (DEPTH, D_RNN, D_MODEL), D_RNN),
        "w_out": nrm(ks[18], (DEPTH, D_MODEL, D_MODEL), D_MODEL),
        "norm2_w": 1.0 + 0.02 * jax.random.normal(ks[19], (DEPTH, D_MODEL), f32),
        "mlp_w1": nrm(ks[20], (DEPTH, D_MODEL, D_FF), D_MODEL),
        "mlp_w2": nrm(ks[21], (DEPTH, D_FF, D_MODEL), D_FF),
        "final_norm_w": 1.0 + 0.02 * jax.random.normal(ks[22], (D_MODEL,), f32),
    }


def reference(x, norm1_w, w_in, cmp_pos_k, cmp_pos_v, cmp_k_w1, cmp_k_w2, cmp_v_w1, cmp_v_w2,
              conv_w, conv_b, lru_w_a, lru_b_a, lru_w_i, lru_b_i, lru_lambda,
              w_up_attn, w_up_rnn, w_out, norm2_w, mlp_w1, mlp_w2, final_norm_w):
    B, S = x.shape[0], x.shape[1]
    for l in range(DEPTH):
        xn = rms_norm(x, norm1_w[l])
        z = xn @ w_in[l]
        (q, k_c, v_c, k_s, v_s, k_w, v_w, g_nsa, xr, gr, g_a, g_b) = jnp.split(z, IN_SPLITS, axis=-1)
        kv_shape = (B, S, N_KV_GROUPS, HEAD_DIM)
        attn = nsa_attention(
            q.reshape(B, S, N_HEADS_A, HEAD_DIM),
            k_c.reshape(kv_shape), v_c.reshape(kv_shape),
            k_s.reshape(kv_shape), v_s.reshape(kv_shape),
            k_w.reshape(kv_shape), v_w.reshape(kv_shape),
            jax.nn.sigmoid(g_nsa).reshape(B, S, N_HEADS_A, 3),
            cmp_pos_k[l], cmp_pos_v[l], cmp_k_w1[l], cmp_k_w2[l], cmp_v_w1[l], cmp_v_w2[l])
        rnn = rg_lru_branch(xr, gr, conv_w[l], conv_b[l], lru_w_a[l], lru_b_a[l],
                            lru_w_i[l], lru_b_i[l], lru_lambda[l])
        merged = jax.nn.sigmoid(g_a) * (attn @ w_up_attn[l]) + jax.nn.sigmoid(g_b) * (rnn @ w_up_rnn[l])
        x = x + merged @ w_out[l]
        hn = rms_norm(x, norm2_w[l])
        x = x + jnp.square(jax.nn.relu(hn @ mlp_w1[l])) @ mlp_w2[l]
    return rms_norm(x, final_norm_w)
```

```cpp
#include <hip/hip_runtime.h>
#include <hip/hip_cooperative_groups.h>
#include <cstdio>
#include <cstdint>
namespace cg = cooperative_groups;
namespace pg8 {
#define PG8_LAS __attribute__((address_space(3)))
typedef unsigned short bf16_t;
typedef short bf16x8 __attribute__((ext_vector_type(8)));
typedef float f32x4 __attribute__((ext_vector_type(4)));
typedef unsigned u32x4 __attribute__((ext_vector_type(4)));
constexpr int BM = 256, BK = 64, HALF = 128, HTB = HALF * BK * 2  , STAGE_BYTES = 8 * HTB, NXCD = 8, WGM = 8;

__host__ __device__ __forceinline__ int lds_byte(int r, int c) { const int st = (r >> 4) * 2 + (c >> 5), rr = r & 15, cc = c & 31, ob = rr * 64 + cc * 2; return st * 1024 + (ob ^ (((ob >> 9) & 1) << 5)); }
__host__ __device__ __forceinline__ void stage_rc(int b, int& R, int& C) { const int st = b / 1024, sb = b % 1024, swz = sb ^ (((sb >> 9) & 1) << 5); R = (st >> 1) * 16 + swz / 64; C = (st & 1) * 32 + (swz % 64) / 2; }
__host__ __device__ __forceinline__ int perm32(int rho) { const int n = rho >> 4, i = rho & 15; return 8 * (i >> 2) + 4 * n + (i & 3); }

struct Unit { int pm, pn; };
struct Gemm { const bf16_t* A; const bf16_t* Bt; int M, N, K, lda; };

struct StaticOrder {
    int nM, nN, nwg, G, c;
    __host__ __device__ void init(int M, int N, int G_, int c_) { nM = M / BM; nN = N / BM; nwg = nM * nN; G = G_; c = c_; }
    __host__ __device__ bool next(int i, Unit& u) const {
        const long L = (long)i * G + c; if (L >= nwg) return false;
        int wgid = (int)L; { const int q = nwg / NXCD, r = nwg % NXCD, xcd = wgid % NXCD, off = wgid / NXCD; wgid = (xcd < r ? xcd * (q + 1) : r * (q + 1) + (xcd - r) * q) + off; }
        const int nig = WGM * nN, gid = wgid / nig, fm = gid * WGM, gsz = (nM - fm) < WGM ? (nM - fm) : WGM;
        u.pm = fm + ((wgid % nig) % gsz); u.pn = (wgid % nig) / gsz; return true;
    }
    __device__ __forceinline__ void a_ready(const Unit&) const {}
    __device__ __forceinline__ void done(const Unit&) const {}
};

__device__ __forceinline__ unsigned cvt_pk_bf16(float lo, float hi) { unsigned r; asm volatile("v_cvt_pk_bf16_f32 %0, %1, %2" : "=v"(r) : "v"(lo), "v"(hi)); return r; }
typedef float f32x2 __attribute__((ext_vector_type(2)));
template <class Epi, class Sched, bool ALIGN_EPI = false, bool SP2 = false>
__device__ __forceinline__ void gemm_phase(PG8_LAS unsigned char* lds, const Gemm g, const Sched& S, const Epi& E, int tid_in) {
    int tid_ = tid_in; asm volatile("" : "+v"(tid_)); const int tid = tid_, wid = __builtin_amdgcn_readfirstlane(tid >> 6), lane = tid & 63, wr = wid >> 2, wc = wid & 3, fr = lane & 15, fq = lane >> 4;
    const int K = g.K, nt = K / BK;
    unsigned voffA[2], voffB[2];
#pragma unroll
    for (int i = 0; i < 2; ++i) { int R, C; stage_rc(tid * 16 + i * 8192, R, C); const int Rb = Epi::PERM ? ((R & ~31) + perm32(R & 31)) : R;
        voffA[i] = (unsigned)(R * g.lda + C) * 2u; voffB[i] = (unsigned)(Rb * K + C) * 2u; }
    const size_t kstep = (size_t)(BK * 2);
    const size_t hstep = (size_t)HALF * K * 2;
    const size_t tstep = 2 * hstep; const size_t hstepA = (size_t)HALF * g.lda * 2, tstepA = 2 * hstepA;
    const unsigned ldsw = (unsigned)wid * 1024u;
    const int aoff = lds_byte(wr * 64 + fr, fq * 8), boff = lds_byte(wc * 32 + fr, fq * 8);
#define PG8_SA(b, h) (((b) * 2 + (h)) * HTB)
#define PG8_SB(b, h) ((4 + (b) * 2 + (h)) * HTB)
#define PG8_STAGE(bufoff, gbase, voff) do { _Pragma("unroll") for (int _i = 0; _i < 2; ++_i) \
        __builtin_amdgcn_global_load_lds((const unsigned*)((const char*)(gbase) + (voff)[_i]), (PG8_LAS unsigned*)(lds + (bufoff) + ldsw + _i * 8192), 16, 0, 0); } while (0)
#define PG8_LDA(dst, b, h) do { _Pragma("unroll") for (int m = 0; m < 4; ++m) _Pragma("unroll") for (int k = 0; k < 2; ++k) dst[m][k] = *(const PG8_LAS bf16x8*)(lds + PG8_SA(b, h) + aoff + m * 2048 + k * 1024); } while (0)
#define PG8_LDB(dst, b, h) do { _Pragma("unroll") for (int n = 0; n < 2; ++n) _Pragma("unroll") for (int k = 0; k < 2; ++k) dst[n][k] = *(const PG8_LAS bf16x8*)(lds + PG8_SB(b, h) + boff + n * 2048 + k * 1024); } while (0)
#define PG8_MMA(ai, bj, At, Bt) do { __builtin_amdgcn_s_setprio(1); _Pragma("unroll") for (int m = 0; m < 4; ++m) _Pragma("unroll") for (int n = 0; n < 2; ++n) _Pragma("unroll") for (int k = 0; k < 2; ++k) \
        acc[ai][bj][m][n] = __builtin_amdgcn_mfma_f32_16x16x32_bf16(Bt[n][k], At[m][k], acc[ai][bj][m][n], 0, 0, 0); __builtin_amdgcn_s_setprio(0); } while (0)
#define PG8_WAIT_V(n) asm volatile("s_waitcnt vmcnt(" #n ")" ::: "memory")
#define PG8_WAIT_L(n) asm volatile("s_waitcnt lgkmcnt(" #n ")" ::: "memory")
#define PG8_BAR __builtin_amdgcn_s_barrier()
#define PG8_SCHED __builtin_amdgcn_sched_barrier(0)
    Unit cur, nxt; int ui = 0;
    if (!S.next(0, cur)) return;
    f32x4 acc[2][2][4][2];
#pragma unroll
    for (int a = 0; a < 2; ++a)
#pragma unroll
        for (int b = 0; b < 2; ++b)
#pragma unroll
            for (int m = 0; m < 4; ++m)
#pragma unroll
                for (int n = 0; n < 2; ++n) acc[a][b][m][n] = (f32x4){0.f, 0.f, 0.f, 0.f};
    bf16x8 At[4][2], B0[2][2], B1[2][2];
    const char* cA = (const char*)g.A + (size_t)cur.pm * tstepA; const char* cB = (const char*)g.Bt + (size_t)cur.pn * tstep;
    S.a_ready(cur);
    if constexpr (SP2) {
        PG8_STAGE(PG8_SB(0, 0), cB, voffB); PG8_STAGE(PG8_SB(0, 1), cB + hstep, voffB); PG8_STAGE(PG8_SA(0, 0), cA, voffA); PG8_STAGE(PG8_SA(0, 1), cA + hstepA, voffA);
        if (wr == 1) PG8_BAR;
        PG8_WAIT_V(2); PG8_BAR;
        PG8_STAGE(PG8_SB(1, 0), cB + kstep, voffB); PG8_STAGE(PG8_SA(1, 0), cA + kstep, voffA); PG8_STAGE(PG8_SB(1, 1), cB + hstep + kstep, voffB);
        PG8_WAIT_V(6); PG8_BAR;
    } else {
        PG8_STAGE(PG8_SB(0, 0), cB, voffB); PG8_STAGE(PG8_SA(0, 0), cA, voffA); PG8_STAGE(PG8_SB(0, 1), cB + hstep, voffB); PG8_STAGE(PG8_SA(0, 1), cA + hstepA, voffA);
        if (wr == 1) PG8_BAR;
        PG8_WAIT_V(4); PG8_BAR;
        PG8_STAGE(PG8_SB(1, 0), cB + kstep, voffB); PG8_STAGE(PG8_SA(1, 0), cA + kstep, voffA); PG8_STAGE(PG8_SB(1, 1), cB + hstep + kstep, voffB);
        PG8_WAIT_V(6); PG8_BAR;
    }
    for (;;) {
        const bool has_next = S.next(ui + 1, nxt);
        const char* nA = has_next ? (const char*)g.A + (size_t)nxt.pm * tstepA : cA; const char* nB = has_next ? (const char*)g.Bt + (size_t)nxt.pn * tstep : cB;
        for (int t = 0; t < nt; t += 2) {
            const bool last = (t == nt - 2);
            const char* a1 = cA + (size_t)(t + 1) * kstep;
            const char* a2 = last ? nA : cA + (size_t)(t + 2) * kstep; const char* b2 = last ? nB : cB + (size_t)(t + 2) * kstep;
            const char* a3 = a2 + kstep; const char* b3 = b2 + kstep;
            if (last && has_next) S.a_ready(nxt);
            if constexpr (SP2) {
            PG8_LDB(B0, 0, 0); PG8_LDB(B1, 0, 1); PG8_SCHED; PG8_LDA(At, 0, 0); PG8_STAGE(PG8_SA(1, 1), a1 + hstepA, voffA);
            PG8_WAIT_V(8); PG8_WAIT_L(0); PG8_BAR; PG8_MMA(0, 0, At, B0); PG8_MMA(0, 1, At, B1); PG8_BAR; PG8_SCHED;
            PG8_LDA(At, 0, 1); PG8_STAGE(PG8_SB(0, 0), b2, voffB); PG8_STAGE(PG8_SB(0, 1), b2 + hstep, voffB); PG8_STAGE(PG8_SA(0, 0), a2, voffA);
            PG8_WAIT_V(8); PG8_WAIT_L(0); PG8_BAR; PG8_MMA(1, 0, At, B0); PG8_MMA(1, 1, At, B1); PG8_BAR; PG8_SCHED;
            PG8_LDB(B0, 1, 0); PG8_LDB(B1, 1, 1); PG8_SCHED; PG8_LDA(At, 1, 0); PG8_STAGE(PG8_SA(0, 1), a2 + hstepA, voffA);
            PG8_WAIT_V(8); PG8_WAIT_L(0); PG8_BAR; PG8_MMA(0, 0, At, B0); PG8_MMA(0, 1, At, B1); PG8_BAR; PG8_SCHED;
            PG8_LDA(At, 1, 1); PG8_STAGE(PG8_SB(1, 0), b3, voffB); PG8_STAGE(PG8_SB(1, 1), b3 + hstep, voffB); PG8_STAGE(PG8_SA(1, 0), a3, voffA);
            PG8_WAIT_V(8); PG8_WAIT_L(0); PG8_BAR; PG8_MMA(1, 0, At, B0); PG8_MMA(1, 1, At, B1); PG8_BAR; PG8_SCHED;
            } else {
            PG8_LDB(B0, 0, 0); PG8_SCHED; PG8_LDA(At, 0, 0); PG8_STAGE(PG8_SA(1, 1), a1 + hstepA, voffA);
            PG8_WAIT_L(8); PG8_BAR; PG8_WAIT_L(0); PG8_MMA(0, 0, At, B0); PG8_BAR; PG8_SCHED;
            PG8_LDB(B1, 0, 1); PG8_STAGE(PG8_SB(0, 0), b2, voffB);
            PG8_BAR; PG8_WAIT_L(0); PG8_MMA(0, 1, At, B1); PG8_BAR;
            PG8_LDA(At, 0, 1); PG8_STAGE(PG8_SA(0, 0), a2, voffA);
            PG8_BAR; PG8_WAIT_L(0); PG8_MMA(1, 0, At, B0); PG8_BAR; PG8_SCHED;
            PG8_STAGE(PG8_SB(0, 1), b2 + hstep, voffB);
            PG8_WAIT_V(6); PG8_BAR; PG8_MMA(1, 1, At, B1); PG8_BAR;
            PG8_LDB(B0, 1, 0); PG8_SCHED; PG8_LDA(At, 1, 0); PG8_STAGE(PG8_SA(0, 1), a2 + hstepA, voffA);
            PG8_WAIT_L(8); PG8_BAR; PG8_WAIT_L(0); PG8_MMA(0, 0, At, B0); PG8_BAR; PG8_SCHED;
            PG8_LDB(B1, 1, 1); PG8_STAGE(PG8_SB(1, 0), b3, voffB);
            PG8_BAR; PG8_WAIT_L(0); PG8_MMA(0, 1, At, B1); PG8_BAR;
            PG8_LDA(At, 1, 1); PG8_STAGE(PG8_SA(1, 0), a3, voffA);
            PG8_BAR; PG8_WAIT_L(0); PG8_MMA(1, 0, At, B0); PG8_BAR; PG8_SCHED;
            PG8_STAGE(PG8_SB(1, 1), b3 + hstep, voffB);
            PG8_WAIT_V(6); PG8_BAR; PG8_MMA(1, 1, At, B1); PG8_BAR;
            }
        }
        if constexpr (ALIGN_EPI) { if (wr == 0) PG8_BAR; }
        if constexpr (!Epi::AFTER_DRAIN) { E(acc, cur, wr, wc, fr, fq); S.done(cur); }
        if (!has_next) break;
#pragma unroll
        for (int a = 0; a < 2; ++a)
#pragma unroll
            for (int b = 0; b < 2; ++b)
#pragma unroll
                for (int m = 0; m < 4; ++m)
#pragma unroll
                    for (int n = 0; n < 2; ++n) acc[a][b][m][n] = (f32x4){0.f, 0.f, 0.f, 0.f};
        cur = nxt; cA = nA; cB = nB; ++ui;
        if constexpr (ALIGN_EPI) { if (wr == 1) PG8_BAR; }
    }
    PG8_WAIT_V(0);
    if constexpr (!ALIGN_EPI) { if (wr == 0) PG8_BAR; }
    PG8_BAR;
    if constexpr (Epi::AFTER_DRAIN) { E.fused(acc, cur, wr, wc, fr, fq, lds, wid, lane); S.done(cur); }
#undef PG8_SA
#undef PG8_SB
#undef PG8_STAGE
#undef PG8_LDA
#undef PG8_LDB
#undef PG8_MMA
#undef PG8_WAIT_V
#undef PG8_WAIT_L
#undef PG8_BAR
#undef PG8_SCHED
}
}
using pg8::bf16_t; using pg8::bf16x8; using pg8::f32x4; using pg8::u32x4;
typedef float f32x16 __attribute__((ext_vector_type(16)));
typedef unsigned u32x2 __attribute__((ext_vector_type(2)));
typedef short s16x4 __attribute__((ext_vector_type(4)));

constexpr int BATCH = 4, SEQ = 4096, DM = 1024, TOK = BATCH * SEQ, DEPTH = 2, DFF = 4096;
constexpr int LDZ = 5376, NIN = 5632, DIN = 5400;
constexpr int ZQ = 0, ZKC = 512, ZVC = 640, ZKS = 768, ZVS = 896, ZKW = 1024, ZVW = 1152, ZXR = 1280, ZGR = 2304, ZGA = 3328, ZGB = 4352;
constexpr float EPSN = 1e-6f;
constexpr float QSCALE = 0.125f * 1.4426950408889634f;
constexpr int NTHREADS = 512;
constexpr int LDS_BYTES = 147456;

constexpr size_t MiB = 1u << 20;
constexpr size_t W_IN = 0, W_UPA = 11 * MiB, W_UPR = 12 * MiB, W_OUT = 14 * MiB, W_1 = 16 * MiB, W_2 = 24 * MiB, W_CK1 = 32 * MiB, W_CV1 = 33 * MiB,
                 W_CK2 = 34 * MiB, W_CV2 = 34 * MiB + 32768, W_A = 34 * MiB + 65536, W_I = 34 * MiB + 65536 + 131072;
constexpr size_t WS_W = 0, WS_Z = 36 * MiB, WS_XB = 204 * MiB, WS_GN = 236 * MiB, WS_SSQ = 238 * MiB, WS_KC = 243 * MiB, WS_VCT = 243 * MiB + 262144,
                 WS_VT = 244 * MiB, WS_AGG = 252 * MiB, WS_END = 254 * MiB;

struct Args { const float* in[23]; float* out; unsigned char* ws; };
typedef const __attribute__((address_space(4))) Args* ArgsP;
__device__ __forceinline__ int tid_now(int wave_s) { int t; asm volatile("v_mbcnt_lo_u32_b32 %0, -1, 0\n\tv_mbcnt_hi_u32_b32 %0, -1, %0\n\tv_lshl_add_u32 %0, %1, 6, %0" : "=&v"(t) : "s"(wave_s)); return t; }
__device__ __forceinline__ Args load_args() {
    Args r{};
#if defined(__HIP_DEVICE_COMPILE__)
    ArgsP p = (ArgsP)__builtin_amdgcn_kernarg_segment_ptr(); asm volatile("" : "+s"(p));
#pragma unroll
    for (int i = 0; i < 23; ++i) r.in[i] = p->in[i];
    r.out = p->out; r.ws = p->ws;
#endif
    return r;
}

__device__ __forceinline__ unsigned f2bf(float f) { unsigned u = __builtin_bit_cast(unsigned, f); return (u + 0x7fffu + ((u >> 16) & 1u)) >> 16; }
__device__ __forceinline__ unsigned pk2(float lo, float hi) { return pg8::cvt_pk_bf16(lo, hi); }
__device__ __forceinline__ float bf2f(unsigned short v) { return __builtin_bit_cast(float, (unsigned)v << 16); }
__device__ __forceinline__ float bflo(unsigned v) { return __builtin_bit_cast(float, v << 16); }
__device__ __forceinline__ float bfhi(unsigned v) { return __builtin_bit_cast(float, v & 0xffff0000u); }
__device__ __forceinline__ float sigmoidf_(float x) { return 1.0f / (1.0f + __expf(-x)); }
__device__ __forceinline__ float gelu_tanh(float x) {
    const float y = 0.7978845608028654f * (x + 0.044715f * x * x * x);
    const float e = __expf(2.0f * y);
    const float th = 1.0f - 2.0f / (e + 1.0f);
    return 0.5f * x * (1.0f + th);
}
__device__ __forceinline__ float wave_sum(float v) {
#pragma unroll
    for (int o = 1; o < 64; o <<= 1) v += __shfl_xor(v, o);
    return v;
}
__device__ __forceinline__ float rstd_from_ssq(const float* p) {
    const f32x4 a = *(const f32x4*)p, b = *(const f32x4*)(p + 4), c = *(const f32x4*)(p + 8), d = *(const f32x4*)(p + 12);
    const float s = ((a.x + a.y) + (a.z + a.w)) + ((b.x + b.y) + (b.z + b.w)) + ((c.x + c.y) + (c.z + c.w)) + ((d.x + d.y) + (d.z + d.w));
    return rsqrtf(s * (1.0f / 1024.0f) + EPSN);
}

struct EpiIn {
    static constexpr bool PERM = true, AFTER_DRAIN = false;
    bf16_t* Z; float* GN; const float* rtab; mutable int ui;
    __device__ __forceinline__ void operator()(const f32x4 (&acc)[2][2][4][2], const pg8::Unit& u, int wr, int wc, int fr, int fq) const {
        const int row0 = u.pm * 256 + wr * 64 + fr;
        const float* rt = rtab + ui * 256 + wr * 64 + fr; ++ui;
#pragma unroll
        for (int ai = 0; ai < 2; ++ai)
#pragma unroll
            for (int m = 0; m < 4; ++m) {
                const int row = row0 + ai * 128 + m * 16;
                const float rstd = rt[ai * 128 + m * 16];
                asm volatile("" ::: "memory");
                if (u.pn < 21) {
                    const float sc = rstd * (u.pn < 2 ? QSCALE : 1.0f);
                    bf16_t* rowp = Z + (size_t)row * LDZ + u.pn * 256 + wc * 32 + 8 * fq;
#pragma unroll
                    for (int bj = 0; bj < 2; ++bj) {
                        const f32x4 v0 = acc[ai][bj][m][0] * sc, v1 = acc[ai][bj][m][1] * sc;
                        u32x4 w; w.x = pk2(v0[0], v0[1]); w.y = pk2(v0[2], v0[3]); w.z = pk2(v1[0], v1[1]); w.w = pk2(v1[2], v1[3]);
                        *(u32x4*)(rowp + bj * 128) = w;
                    }
                } else if (wc == 0) {
                    float* gp = GN + (size_t)row * 32 + 8 * fq;
#pragma unroll
                    for (int n = 0; n < 2; ++n) {
                        const f32x4 v = acc[ai][0][m][n] * rstd;
                        f32x4 o; o.x = sigmoidf_(v.x); o.y = sigmoidf_(v.y); o.z = sigmoidf_(v.z); o.w = sigmoidf_(v.w);
                        *(f32x4*)(gp + 4 * n) = o;
                    }
                }
            }
    }
};
template <int MODE>
struct EpiUp {
    static constexpr bool PERM = true, AFTER_DRAIN = false;
    bf16_t* Z;
    __device__ __forceinline__ void operator()(const f32x4 (&acc)[2][2][4][2], const pg8::Unit& u, int wr, int wc, int fr, int fq) const {
        const int row0 = u.pm * 256 + wr * 64 + fr;
        const int col0 = u.pn * 256 + wc * 32 + 8 * fq;
#pragma unroll
        for (int ai = 0; ai < 2; ++ai)
#pragma unroll
            for (int m = 0; m < 4; ++m) {
                bf16_t* rowp = Z + (size_t)(row0 + ai * 128 + m * 16) * LDZ + col0;
                asm volatile("" ::: "memory");
#pragma unroll
                for (int bj = 0; bj < 2; ++bj) {
                    const u32x4 gg = *(const u32x4*)(rowp + (MODE == 0 ? ZGA : ZGB) + bj * 128);
                    float g[8] = {bflo(gg.x), bfhi(gg.x), bflo(gg.y), bfhi(gg.y), bflo(gg.z), bfhi(gg.z), bflo(gg.w), bfhi(gg.w)};
                    float v[8];
#pragma unroll
                    for (int e = 0; e < 4; ++e) { v[e] = sigmoidf_(g[e]) * acc[ai][bj][m][0][e]; v[4 + e] = sigmoidf_(g[4 + e]) * acc[ai][bj][m][1][e]; }
                    if (MODE == 1) {
                        const u32x4 tt = *(const u32x4*)(rowp + ZXR + bj * 128);
                        v[0] += bflo(tt.x); v[1] += bfhi(tt.x); v[2] += bflo(tt.y); v[3] += bfhi(tt.y); v[4] += bflo(tt.z); v[5] += bfhi(tt.z); v[6] += bflo(tt.w); v[7] += bfhi(tt.w);
                    }
                    u32x4 w; w.x = pk2(v[0], v[1]); w.y = pk2(v[2], v[3]); w.z = pk2(v[4], v[5]); w.w = pk2(v[6], v[7]);
                    *(u32x4*)(rowp + ZXR + bj * 128) = w;
                }
            }
    }
};
struct EpiRes {
    static constexpr bool PERM = false, AFTER_DRAIN = false;
    float* X; bf16_t* XB; float* ssq;
    __device__ __forceinline__ void operator()(const f32x4 (&acc)[2][2][4][2], const pg8::Unit& u, int wr, int wc, int fr, int fq) const {
        const int row0 = u.pm * 256 + wr * 64 + fr;
        const int col0 = u.pn * 256 + wc * 32 + 4 * fq;
#pragma unroll
        for (int ai = 0; ai < 2; ++ai)
#pragma unroll
            for (int m = 0; m < 4; ++m) {
                const int row = row0 + ai * 128 + m * 16;
                float ss = 0.f;
                asm volatile("" ::: "memory");
#pragma unroll
                for (int bj = 0; bj < 2; ++bj)
#pragma unroll
                    for (int n = 0; n < 2; ++n) {
                        const size_t off = (size_t)row * DM + col0 + bj * 128 + n * 16;
                        f32x4 v = *(const f32x4*)(X + off) + acc[ai][bj][m][n];
                        *(f32x4*)(X + off) = v;
                        u32x2 w; w.x = pk2(v.x, v.y); w.y = pk2(v.z, v.w);
                        *(u32x2*)(XB + off) = w;
                        ss += (v.x * v.x + v.y * v.y) + (v.z * v.z + v.w * v.w);
                    }
                ss += __shfl_xor(ss, 16); ss += __shfl_xor(ss, 32);
                if (fq == 0) ssq[(size_t)row * 16 + u.pn * 4 + wc] = ss;
            }
    }
};
struct EpiMlpUp {
    static constexpr bool PERM = true, AFTER_DRAIN = false;
    bf16_t* H; const float* rtab; mutable int ui;
    __device__ __forceinline__ void operator()(const f32x4 (&acc)[2][2][4][2], const pg8::Unit& u, int wr, int wc, int fr, int fq) const {
        const int row0 = u.pm * 256 + wr * 64 + fr;
        const int col0 = u.pn * 256 + wc * 32 + 8 * fq;
        const float* rt = rtab + ui * 256 + wr * 64 + fr; ++ui;
#pragma unroll
        for (int ai = 0; ai < 2; ++ai)
#pragma unroll
            for (int m = 0; m < 4; ++m) {
                const int row = row0 + ai * 128 + m * 16;
                const float rstd = rt[ai * 128 + m * 16];
                asm volatile("" ::: "memory");
                bf16_t* rowp = H + (size_t)row * DFF + col0;
#pragma unroll
                for (int bj = 0; bj < 2; ++bj) {
                    f32x4 v0 = acc[ai][bj][m][0] * rstd, v1 = acc[ai][bj][m][1] * rstd;
#pragma unroll
                    for (int e = 0; e < 4; ++e) { const float a = fmaxf(v0[e], 0.f), b = fmaxf(v1[e], 0.f); v0[e] = a * a; v1[e] = b * b; }
                    u32x4 w; w.x = pk2(v0[0], v0[1]); w.y = pk2(v0[2], v0[3]); w.z = pk2(v1[0], v1[1]); w.w = pk2(v1[2], v1[3]);
                    *(u32x4*)(rowp + bj * 128) = w;
                }
            }
    }
};

constexpr int RTAB_OFF = 131072;
__device__ __forceinline__ void fill_rtab(const pg8::StaticOrder& S, const float* ssq, float* tab, int tid) {
    pg8::Unit u;
    for (int i = 0; S.next(i, u); ++i)
        if (tid < 256) tab[i * 256 + tid] = rstd_from_ssq(ssq + (size_t)(u.pm * 256 + tid) * 16);
    __syncthreads();
}
__device__ __forceinline__ void tr_item(const float* W, int ldn, int k0, int src_n0, int nvalid, const float* ks, bf16_t* dst, int dstK, int dst_row0, float* scr, int lane) {
    const int n = lane & 31;
#pragma unroll 8
    for (int i = 0; i < 32; ++i) {
        const int kk = 2 * i + (lane >> 5);
        float v = (n < nvalid) ? W[(size_t)(k0 + kk) * ldn + src_n0 + n] : 0.f;
        if (ks) v *= ks[k0 + kk];
        scr[kk * 33 + n] = v;
    }
    asm volatile("s_waitcnt lgkmcnt(0)" ::: "memory");
    const int c = lane & 7;
#pragma unroll
    for (int j = 0; j < 4; ++j) {
        const int nn = (lane >> 3) + 8 * j; const float* s = scr + (8 * c) * 33 + nn;
        u32x4 o; o.x = pk2(s[0 * 33], s[1 * 33]); o.y = pk2(s[2 * 33], s[3 * 33]); o.z = pk2(s[4 * 33], s[5 * 33]); o.w = pk2(s[6 * 33], s[7 * 33]);
        *(u32x4*)(dst + (size_t)(dst_row0 + nn) * dstK + k0 + 8 * c) = o;
    }
    asm volatile("s_waitcnt lgkmcnt(0)" ::: "memory");
}

__device__ __forceinline__ void phase_weights(const Args& a, int l, unsigned char* lds, int gw, int ngw, int wave, int lane) {
    float* scr = (float*)(lds + wave * 16384);
    unsigned char* W = a.ws + WS_W;
    constexpr int I_IN = 16 * 176, I_UPA = 8 * 32, I_UPR = 16 * 32, I_OUT = 16 * 32, I_1 = 16 * 128, I_2 = 64 * 32, I_C1 = 32 * 8, I_C2 = 4 * 2, I_L = 16 * 2;
    constexpr int NITEMS = I_IN + I_UPA + I_UPR + I_OUT + I_1 + I_2 + 2 * I_C1 + 2 * I_C2 + 2 * I_L;
    for (int it = gw; it < NITEMS; it += ngw) {
        int r = it;
        if (r < I_IN) {
            const int kb = r / 176, nb = r % 176, n0 = nb * 32;
            int src, nv;
            if (n0 < 1280) { src = n0; nv = 32; } else if (n0 < 5376) { src = n0 + 24; nv = 32; } else if (n0 == 5376) { src = 1280; nv = 24; } else { src = 0; nv = 0; }
            tr_item(a.in[2] + (size_t)l * DM * DIN, DIN, kb * 64, src, nv, a.in[1] + l * DM, (bf16_t*)(W + W_IN), 1024, n0, scr, lane); continue;
        }
        r -= I_IN;
        if (r < I_UPA) { tr_item(a.in[16] + (size_t)l * 512 * 1024, 1024, (r / 32) * 64, (r % 32) * 32, 32, nullptr, (bf16_t*)(W + W_UPA), 512, (r % 32) * 32, scr, lane); continue; }
        r -= I_UPA;
        if (r < I_UPR) { tr_item(a.in[17] + (size_t)l * 1024 * 1024, 1024, (r / 32) * 64, (r % 32) * 32, 32, nullptr, (bf16_t*)(W + W_UPR), 1024, (r % 32) * 32, scr, lane); continue; }
        r -= I_UPR;
        if (r < I_OUT) { tr_item(a.in[18] + (size_t)l * 1024 * 1024, 1024, (r / 32) * 64, (r % 32) * 32, 32, nullptr, (bf16_t*)(W + W_OUT), 1024, (r % 32) * 32, scr, lane); continue; }
        r -= I_OUT;
        if (r < I_1) { tr_item(a.in[20] + (size_t)l * 1024 * 4096, 4096, (r / 128) * 64, (r % 128) * 32, 32, a.in[19] + l * DM, (bf16_t*)(W + W_1), 1024, (r % 128) * 32, scr, lane); continue; }
        r -= I_1;
        if (r < I_2) { tr_item(a.in[21] + (size_t)l * 4096 * 1024, 1024, (r / 32) * 64, (r % 32) * 32, 32, nullptr, (bf16_t*)(W + W_2), 4096, (r % 32) * 32, scr, lane); continue; }
        r -= I_2;
        if (r < I_C1) { tr_item(a.in[5] + (size_t)l * 2048 * 256, 256, (r / 8) * 64, (r % 8) * 32, 32, nullptr, (bf16_t*)(W + W_CK1), 2048, (r % 8) * 32, scr, lane); continue; }
        r -= I_C1;
        if (r < I_C1) { tr_item(a.in[7] + (size_t)l * 2048 * 256, 256, (r / 8) * 64, (r % 8) * 32, 32, nullptr, (bf16_t*)(W + W_CV1), 2048, (r % 8) * 32, scr, lane); continue; }
        r -= I_C1;
        if (r < I_C2) { tr_item(a.in[6] + (size_t)l * 256 * 64, 64, (r / 2) * 64, (r % 2) * 32, 32, nullptr, (bf16_t*)(W + W_CK2), 256, (r % 2) * 32, scr, lane); continue; }
        r -= I_C2;
        if (r < I_C2) { tr_item(a.in[8] + (size_t)l * 256 * 64, 64, (r / 2) * 64, (r % 2) * 32, 32, nullptr, (bf16_t*)(W + W_CV2), 256, (r % 2) * 32, scr, lane); continue; }
        r -= I_C2;
        if (r < I_L) { const int h = r / 2; tr_item(a.in[11] + (size_t)l * 65536 + h * 4096, 64, 0, (r % 2) * 32, 32, nullptr, (bf16_t*)(W + W_A) + h * 4096, 64, (r % 2) * 32, scr, lane); continue; }
        r -= I_L;
        { const int h = r / 2; tr_item(a.in[13] + (size_t)l * 65536 + h * 4096, 64, 0, (r % 2) * 32, 32, nullptr, (bf16_t*)(W + W_I) + h * 4096, 64, (r % 2) * 32, scr, lane); }
    }
}

__device__ __forceinline__ void phase_x0(const Args& a, int gw, int ngw, int lane) {
    const float* x = a.in[0]; float* X = a.out; bf16_t* XB = (bf16_t*)(a.ws + WS_XB); float* ssq = (float*)(a.ws + WS_SSQ);
    for (int row = gw; row < TOK; row += ngw) {
        const f32x4* xr = (const f32x4*)(x + (size_t)row * DM) + lane;
        f32x4 v[4]; float s = 0.f;
#pragma unroll
        for (int j = 0; j < 4; ++j) { v[j] = xr[64 * j]; s += (v[j].x * v[j].x + v[j].y * v[j].y) + (v[j].z * v[j].z + v[j].w * v[j].w); }
        s = wave_sum(s);
        f32x4* xo = (f32x4*)(X + (size_t)row * DM) + lane;
        u32x2* bo = (u32x2*)(XB + (size_t)row * DM) + lane;
#pragma unroll
        for (int j = 0; j < 4; ++j) { xo[64 * j] = v[j]; u32x2 w; w.x = pk2(v[j].x, v[j].y); w.y = pk2(v[j].z, v[j].w); bo[64 * j] = w; }
        if (lane < 16) ssq[(size_t)row * 16 + lane] = (lane == 0) ? s : 0.f;
    }
}
__device__ __forceinline__ void phase_final(const Args& a, int gw, int ngw, int lane) {
    float* X = a.out; const float* ssq = (const float*)(a.ws + WS_SSQ) + (size_t)4 * TOK * 16; const float* w = a.in[22];
    f32x4 wv[4];
#pragma unroll
    for (int j = 0; j < 4; ++j) wv[j] = ((const f32x4*)w)[lane + 64 * j];
    for (int row = gw; row < TOK; row += ngw) {
        const float rstd = rstd_from_ssq(ssq + (size_t)row * 16);
        f32x4* xo = (f32x4*)(X + (size_t)row * DM) + lane;
#pragma unroll
        for (int j = 0; j < 4; ++j) { f32x4 v = xo[64 * j]; v = v * rstd * wv[j]; xo[64 * j] = v; }
    }
}

__device__ __forceinline__ void vt_item(const Args& a, int item, unsigned char* lds, int tid) {
    const int tb = item & 63, g = (item >> 6) & 1, kind = (item >> 7) & 1, b = item >> 8;
    const bf16_t* Z = (const bf16_t*)(a.ws + WS_Z); bf16_t* VT = (bf16_t*)(a.ws + WS_VT);
    bf16_t* T = (bf16_t*)lds;
    const int row = tid >> 3, ch = tid & 7;
    const u32x4 v = *(const u32x4*)(Z + (size_t)(b * SEQ + tb * 64 + row) * LDZ + (kind ? ZVW : ZVS) + g * 64 + ch * 8);
    const unsigned vv[4] = {v.x, v.y, v.z, v.w};
#pragma unroll
    for (int e = 0; e < 4; ++e) { T[(ch * 8 + 2 * e) * 72 + row] = (bf16_t)(vv[e] & 0xffffu); T[(ch * 8 + 2 * e + 1) * 72 + row] = (bf16_t)(vv[e] >> 16); }
    __syncthreads();
    const u32x4 o = *(const u32x4*)(T + row * 72 + ch * 8);
    *(u32x4*)(VT + ((size_t)((b * 2 + kind) * 2 + g) * 64 + row) * SEQ + tb * 64 + ch * 8) = o;
    __syncthreads();
}

__device__ __forceinline__ void cmp_item(const Args& a, int l, int item, unsigned char* lds, int tid) {
    const int wid = tid >> 6, lane = tid & 63, fr = lane & 15, fq = lane >> 4;
    const int nct = item & 15, g = (item >> 4) & 1, b = (item >> 5) & 3, kv = item >> 7;
    const int nc0 = nct * 16;
    const bf16_t* Z = (const bf16_t*)(a.ws + WS_Z);
    const bf16_t* W1 = (const bf16_t*)(a.ws + WS_W + (kv ? W_CV1 : W_CK1));
    const bf16_t* W2 = (const bf16_t*)(a.ws + WS_W + (kv ? W_CV2 : W_CK2));
    const float* pos = (kv ? a.in[4] : a.in[3]) + (size_t)l * 2048;
    bf16_t* hid = (bf16_t*)lds;
    const int nc = nc0 + fr; const bool rowok = nc < 255;
    const bf16_t* arow = Z + (size_t)(b * SEQ + 16 * (rowok ? nc : 0)) * LDZ + (kv ? ZVC : ZKC) + g * 64;
    const bf16_t* b0 = W1 + (size_t)(32 * wid + fr) * 2048 + 8 * fq;
    const bf16_t* b1 = b0 + (size_t)16 * 2048;
    f32x4 acc0 = {0.f, 0.f, 0.f, 0.f}, acc1 = {0.f, 0.f, 0.f, 0.f};
#pragma unroll 4
    for (int ks = 0; ks < 64; ++ks) {
        const int i = ks >> 1, d = (ks & 1) * 32 + 8 * fq;
        const u32x4 av = *(const u32x4*)(arow + (size_t)i * LDZ + d);
        const f32x4 p0 = *(const f32x4*)(pos + i * 64 + d), p1 = *(const f32x4*)(pos + i * 64 + d + 4);
        u32x4 aw;
        aw.x = pk2(bflo(av.x) + p0.x, bfhi(av.x) + p0.y); aw.y = pk2(bflo(av.y) + p0.z, bfhi(av.y) + p0.w);
        aw.z = pk2(bflo(av.z) + p1.x, bfhi(av.z) + p1.y); aw.w = pk2(bflo(av.w) + p1.z, bfhi(av.w) + p1.w);
        const bf16x8 af = __builtin_bit_cast(bf16x8, aw);
        const bf16x8 bf0 = *(const bf16x8*)(b0 + ks * 32), bf1 = *(const bf16x8*)(b1 + ks * 32);
        acc0 = __builtin_amdgcn_mfma_f32_16x16x32_bf16(af, bf0, acc0, 0, 0, 0);
        acc1 = __builtin_amdgcn_mfma_f32_16x16x32_bf16(af, bf1, acc1, 0, 0, 0);
    }
#pragma unroll
    for (int e = 0; e < 4; ++e) {
        hid[(4 * fq + e) * 264 + 32 * wid + fr] = (bf16_t)f2bf(gelu_tanh(acc0[e]));
        hid[(4 * fq + e) * 264 + 32 * wid + 16 + fr] = (bf16_t)f2bf(gelu_tanh(acc1[e]));
    }
    __syncthreads();
    if (wid < 4) {
        f32x4 acc = {0.f, 0.f, 0.f, 0.f};
        const bf16_t* bw = W2 + (size_t)(16 * wid + fr) * 256 + 8 * fq;
#pragma unroll
        for (int ks = 0; ks < 8; ++ks) {
            const bf16x8 af = *(const bf16x8*)(hid + fr * 264 + ks * 32 + 8 * fq);
            const bf16x8 bf = *(const bf16x8*)(bw + ks * 32);
            acc = __builtin_amdgcn_mfma_f32_16x16x32_bf16(af, bf, acc, 0, 0, 0);
        }
        const int d = 16 * wid + fr;
        float o[4];
#pragma unroll
        for (int e = 0; e < 4; ++e) o[e] = (nc0 + 4 * fq + e < 255) ? acc[e] : 0.f;
        if (kv == 0) {
            bf16_t* KC = (bf16_t*)(a.ws + WS_KC) + (size_t)((b * 2 + g) * 256) * 64;
#pragma unroll
            for (int e = 0; e < 4; ++e) KC[(size_t)(nc0 + 4 * fq + e) * 64 + d] = (bf16_t)f2bf(o[e]);
        } else {
            bf16_t* VCT = (bf16_t*)(a.ws + WS_VCT) + (size_t)((b * 2 + g) * 64) * 256;
            u32x2 w; w.x = pk2(o[0], o[1]); w.y = pk2(o[2], o[3]);
            *(u32x2*)(VCT + (size_t)d * 256 + nc0 + 4 * fq) = w;
        }
    }
    __syncthreads();
}

template <int PASS>
__device__ __forceinline__ void rnn_item(const Args& a, int l, int item, unsigned char* lds, int tid) {
    const int wid = tid >> 6, lane = tid & 63, fr = lane & 15, fq = lane >> 4;
    const int h = item & 15, c = (item >> 4) & 63, b = item >> 10;
    bf16_t* Z = (bf16_t*)(a.ws + WS_Z);
    float* XRf = (float*)lds;
    float* XC = (float*)(lds + 17408);
    bf16_t* XCB = (bf16_t*)(lds + 17408 + 16640);
    float* AA = (float*)(lds + 43264);
    float* BB = (float*)(lds + 43264 + 16640);
    float* SEGA = (float*)(lds + 76544);
    float* SEGH = SEGA + 512;
    float* CAR = SEGH + 512;
    for (int q = tid; q < 67 * 8; q += NTHREADS) {
        const int rr = q >> 3, ch = q & 7; const int t = c * 64 - 3 + rr;
        u32x4 v = {0u, 0u, 0u, 0u};
        if (t >= 0) v = *(const u32x4*)(Z + (size_t)(b * SEQ + t) * LDZ + ZXR + h * 64 + ch * 8);
        float* d = XRf + rr * 64 + ch * 8;
        d[0] = bflo(v.x); d[1] = bfhi(v.x); d[2] = bflo(v.y); d[3] = bfhi(v.y); d[4] = bflo(v.z); d[5] = bfhi(v.z); d[6] = bflo(v.w); d[7] = bfhi(v.w);
    }
    __syncthreads();
    {
        const int ch = tid & 63, tg = tid >> 6, cg_ = h * 64 + ch;
        const float* cw = a.in[9] + (size_t)l * 4 * DM + cg_;
        const float w0 = cw[0], w1 = cw[DM], w2 = cw[2 * DM], w3 = cw[3 * DM], cb = a.in[10][l * DM + cg_];
#pragma unroll
        for (int k = 0; k < 8; ++k) {
            const int tok = tg * 8 + k;
            float xc = cb;
            xc += XRf[(tok + 0) * 64 + ch] * w0; xc += XRf[(tok + 1) * 64 + ch] * w1; xc += XRf[(tok + 2) * 64 + ch] * w2; xc += XRf[(tok + 3) * 64 + ch] * w3;
            XC[tok * 65 + ch] = xc; XCB[tok * 72 + ch] = (bf16_t)f2bf(xc);
        }
    }
    __syncthreads();
    {
        const bf16_t* WA = (const bf16_t*)(a.ws + WS_W + W_A) + h * 4096;
        const bf16_t* WI = (const bf16_t*)(a.ws + WS_W + W_I) + h * 4096;
#pragma unroll
        for (int q = 0; q < 2; ++q) {
            const int pr = 2 * wid + q, mt = pr >> 2, nt = pr & 3;
            f32x4 ca = {0.f, 0.f, 0.f, 0.f}, ci = {0.f, 0.f, 0.f, 0.f};
#pragma unroll
            for (int ks = 0; ks < 2; ++ks) {
                const bf16x8 af = *(const bf16x8*)(XCB + (16 * mt + fr) * 72 + 32 * ks + 8 * fq);
                const bf16x8 ba = *(const bf16x8*)(WA + (16 * nt + fr) * 64 + 32 * ks + 8 * fq);
                const bf16x8 bi = *(const bf16x8*)(WI + (16 * nt + fr) * 64 + 32 * ks + 8 * fq);
                ca = __builtin_amdgcn_mfma_f32_16x16x32_bf16(af, ba, ca, 0, 0, 0);
                ci = __builtin_amdgcn_mfma_f32_16x16x32_bf16(af, bi, ci, 0, 0, 0);
            }
            const int j = 16 * nt + fr, cg_ = h * 64 + j;
            const float ba_ = a.in[12][l * DM + cg_], bi_ = a.in[14][l * DM + cg_], lam = a.in[15][l * DM + cg_];
            const float sp = log1pf(expf(-lam));
#pragma unroll
            for (int e = 0; e < 4; ++e) {
                const int tok = 16 * mt + 4 * fq + e;
                const float r = sigmoidf_(ca[e] + ba_), ig = sigmoidf_(ci[e] + bi_);
                const float log_a = -8.0f * r * sp;
                const float av = expf(log_a);
                const float bt = sqrtf(-expm1f(2.0f * log_a)) * (ig * XC[tok * 65 + j]);
                AA[tok * 65 + j] = av; BB[tok * 65 + j] = bt;
            }
        }
    }
    __syncthreads();
    const int ch = tid & 63, sg = tid >> 6;
    float av[8], bv[8];
    {
        float A = 1.f, H = 0.f;
#pragma unroll
        for (int k = 0; k < 8; ++k) { av[k] = AA[(sg * 8 + k) * 65 + ch]; bv[k] = BB[(sg * 8 + k) * 65 + ch]; H = av[k] * H + bv[k]; A *= av[k]; }
        SEGA[sg * 64 + ch] = A; SEGH[sg * 64 + ch] = H;
    }
    float* AGG = (float*)(a.ws + WS_AGG);
    if (PASS == 2 && tid < 64) {
        float Hc = 0.f;
        for (int cc = 0; cc < c; ++cc) { const float2 ah = *(const float2*)(AGG + ((size_t)(b * 64 + cc) * DM + h * 64 + tid) * 2); Hc = ah.x * Hc + ah.y; }
        CAR[tid] = Hc;
    }
    __syncthreads();
    if (PASS == 1) {
        if (tid < 64) {
            float Ac = 1.f, Hc = 0.f;
#pragma unroll
            for (int s = 0; s < 8; ++s) { const float sa = SEGA[s * 64 + tid]; Hc = sa * Hc + SEGH[s * 64 + tid]; Ac *= sa; }
            float2 o; o.x = Ac; o.y = Hc;
            *(float2*)(AGG + ((size_t)(b * 64 + c) * DM + h * 64 + tid) * 2) = o;
        }
    } else {
        float H = CAR[ch];
        for (int s = 0; s < sg; ++s) H = SEGA[s * 64 + ch] * H + SEGH[s * 64 + ch];
        bf16_t* gp = Z + (size_t)(b * SEQ + c * 64 + sg * 8) * LDZ + ZGR + h * 64 + ch;
#pragma unroll
        for (int k = 0; k < 8; ++k) {
            H = av[k] * H + bv[k];
            const float gate = bf2f(gp[(size_t)k * LDZ]);
            gp[(size_t)k * LDZ] = (bf16_t)f2bf(H * gelu_tanh(gate));
        }
    }
    __syncthreads();
}

constexpr int AL_K = 0, AL_V = 18432, AL_PS = 36864, AL_IMP = 103424, AL_SEL = 119808;
constexpr int PSLD = 260;
constexpr float NEGF = -1e30f;

template <int MODE>
__device__ __forceinline__ void attn_tile(const unsigned char* Kt, const unsigned char* Vt, const bf16x8 (&qr)[4], int lo, int hi, float& m, float& l, float inv,
                                          f32x16& o0, f32x16& o1, float* psrow, int lane) {
    const int r = lane & 31, hh = lane >> 5;
    f32x16 p[2];
#pragma unroll
    for (int kt = 0; kt < 2; ++kt) {
        f32x16 acc = {};
#pragma unroll
        for (int s = 0; s < 4; ++s) {
            const bf16x8 kf = *(const bf16x8*)(Kt + (32 * kt + r) * 144 + (16 * s + 8 * hh) * 2);
            acc = __builtin_amdgcn_mfma_f32_32x32x16_bf16(kf, qr[s], acc, 0, 0, 0);
        }
        p[kt] = acc;
        __builtin_amdgcn_sched_barrier(0);
    }
    const bool full = __all((lo <= 0) && (hi >= 63));
    if (!full) {
        const int lo2 = lo - 4 * hh, hi2 = hi - 4 * hh;
#pragma unroll
        for (int kt = 0; kt < 2; ++kt)
#pragma unroll
            for (int rg = 0; rg < 16; ++rg) { const int kc = 32 * kt + (rg & 3) + 8 * (rg >> 2); if (kc < lo2 || kc > hi2) p[kt][rg] = NEGF; }
    }
    float mn = m;
    if (MODE != 1) {
        float tm = NEGF;
#pragma unroll
        for (int kt = 0; kt < 2; ++kt)
#pragma unroll
            for (int rg = 0; rg < 16; ++rg) tm = fmaxf(tm, p[kt][rg]);
        tm = fmaxf(tm, __shfl_xor(tm, 32));
        mn = fmaxf(m, tm);
        const float alpha = __builtin_amdgcn_exp2f(m - mn);
        l *= alpha;
        if (MODE == 2) { o0 = o0 * alpha; o1 = o1 * alpha; }
        m = mn;
    }
    float sum = 0.f;
#pragma unroll
    for (int kt = 0; kt < 2; ++kt)
#pragma unroll
        for (int rg = 0; rg < 16; ++rg) {
            const float s = p[kt][rg];
            float e = (s > -1e29f) ? __builtin_amdgcn_exp2f(s - mn) : 0.f;
            if (MODE == 1) e *= inv;
            p[kt][rg] = e; sum += e;
        }
    if (MODE != 1) l += sum;
    if (MODE == 0) return;
    if (MODE == 1) {
        float* psrow2 = psrow + 4 * hh;
#pragma unroll
        for (int kt = 0; kt < 2; ++kt)
#pragma unroll
            for (int rg = 0; rg < 16; ++rg) {
                float v = p[kt][rg]; v += __shfl_xor(v, 1); v += __shfl_xor(v, 2);
                if ((lane & 3) == 0) psrow2[32 * kt + (rg & 3) + 8 * (rg >> 2)] = v;
            }
    }
#pragma unroll
    for (int s = 0; s < 4; ++s) {
        const int kt = s >> 1, rb = 8 * (s & 1);
        u32x4 pw;
        pw.x = pk2(p[kt][rb + 0], p[kt][rb + 1]); pw.y = pk2(p[kt][rb + 2], p[kt][rb + 3]); pw.z = pk2(p[kt][rb + 4], p[kt][rb + 5]); pw.w = pk2(p[kt][rb + 6], p[kt][rb + 7]);
        const bf16x8 pf = __builtin_bit_cast(bf16x8, pw);
#pragma unroll
        for (int dt = 0; dt < 2; ++dt) {
            const unsigned char* vp = Vt + (32 * dt + r) * 144 + (16 * s + 4 * hh) * 2;
            const u32x2 v0 = *(const u32x2*)vp, v1 = *(const u32x2*)(vp + 16);
            u32x4 vw; vw.x = v0.x; vw.y = v0.y; vw.z = v1.x; vw.w = v1.y;
            const bf16x8 vf = __builtin_bit_cast(bf16x8, vw);
            if (dt == 0) o0 = __builtin_amdgcn_mfma_f32_32x32x16_bf16(vf, pf, o0, 0, 0, 0);
            else o1 = __builtin_amdgcn_mfma_f32_32x32x16_bf16(vf, pf, o1, 0, 0, 0);
        }
        __builtin_amdgcn_sched_barrier(0);
    }
}

__device__ __forceinline__ void attn_unit(const Args& a, int b, int g, int qt, unsigned char* lds, int tid) {
    const int wid = tid >> 6, lane = tid & 63, hh = lane >> 5;
    const int tokl = (lane & 31) >> 2, head = lane & 3, ti = 8 * wid + tokl, t0 = 64 * qt, t = t0 + ti;
    bf16_t* Z = (bf16_t*)(a.ws + WS_Z);
    const bf16_t* KC = (const bf16_t*)(a.ws + WS_KC) + (size_t)((b * 2 + g) * 256) * 64;
    const bf16_t* VCT = (const bf16_t*)(a.ws + WS_VCT) + (size_t)((b * 2 + g) * 64) * 256;
    const bf16_t* VTs = (const bf16_t*)(a.ws + WS_VT) + ((size_t)((b * 2 + 0) * 2 + g) * 64) * SEQ;
    const bf16_t* VTw = (const bf16_t*)(a.ws + WS_VT) + ((size_t)((b * 2 + 1) * 2 + g) * 64) * SEQ;
    const bf16_t* Zb = Z + (size_t)b * SEQ * LDZ;
    float* PS = (float*)(lds + AL_PS); float* IMP = (float*)(lds + AL_IMP); unsigned long long* SEL = (unsigned long long*)(lds + AL_SEL);
    bf16_t* qrow = Z + (size_t)(b * SEQ + t) * LDZ + ZQ + (g * 4 + head) * 64;
    bf16x8 qr[4];
#pragma unroll
    for (int s = 0; s < 4; ++s) qr[s] = *(const bf16x8*)(qrow + 16 * s + 8 * hh);
    const float* gn = (const float*)(a.ws + WS_GN) + (size_t)(b * SEQ + t) * 32 + (g * 4 + head) * 3;
    const float g0 = gn[0], g1 = gn[1], g2 = gn[2];
    f32x16 out0 = {}, out1 = {};
    const int srow = tid >> 3, sch = tid & 7;
    const int sdst = srow * 144 + sch * 16;
    u32x4 kreg, vreg;
#define ST_STORE(buf) do { *(u32x4*)(lds + AL_K + (buf) * 9216 + sdst) = kreg; *(u32x4*)(lds + AL_V + (buf) * 9216 + sdst) = vreg; } while (0)

    const int nct = (4 * qt + 66) >> 6;
    const int nmax = (t >= 31) ? ((t - 31) >> 4) : -1;
    float m = NEGF, l = 0.f; f32x16 o0 = {}, o1 = {};
#define CMP_LOAD(c) do { kreg = *(const u32x4*)(KC + (size_t)((c) * 64 + srow) * 64 + sch * 8); vreg = *(const u32x4*)(VCT + (size_t)srow * 256 + (c) * 64 + sch * 8); } while (0)
    CMP_LOAD(0); ST_STORE(0); __syncthreads();
    for (int c = 0; c < nct; ++c) {
        if (c + 1 < nct) CMP_LOAD(c + 1);
        attn_tile<0>(lds + AL_K + (c & 1) * 9216, lds + AL_V + (c & 1) * 9216, qr, 0, nmax - 64 * c, m, l, 0.f, o0, o1, nullptr, lane);
        if (c + 1 < nct) ST_STORE((c + 1) & 1);
        __syncthreads();
    }
    {
        const float lt = l + __shfl_xor(l, 32);
        const float inv = lt > 0.f ? 1.0f / lt : 0.f;
        CMP_LOAD(0); ST_STORE(0); __syncthreads();
        for (int c = 0; c < nct; ++c) {
            if (c + 1 < nct) CMP_LOAD(c + 1);
            attn_tile<1>(lds + AL_K + (c & 1) * 9216, lds + AL_V + (c & 1) * 9216, qr, 0, nmax - 64 * c, m, l, inv, o0, o1, PS + ti * PSLD + 64 * c, lane);
            if (c + 1 < nct) ST_STORE((c + 1) & 1);
            __syncthreads();
        }
        out0 = o0 * g0; out1 = o1 * g0;
    }
    if (qt < 16) {
        if (tid < 64) SEL[tid] = (qt == 63) ? ~0ull : ((1ull << (qt + 1)) - 1ull);
    } else {
#pragma unroll 1
        for (int k = 0; k < 8; ++k) {
            const int tk = 8 * wid + k; const float* pr = PS + tk * PSLD; const int j = lane;
            float v = 0.f;
            if (j >= 1 && j <= qt) { const float p0 = pr[4 * j], p1 = pr[4 * j - 1], p2 = pr[4 * j - 2], p3 = pr[4 * j - 3], p4 = pr[4 * j - 4];
                v = ((((((p0 + p1) + p1) + p2) + p2) + p3) + p3) + p4; }
            IMP[tk * 64 + j] = v;
        }
        __syncthreads();
#pragma unroll 1
        for (int k = 0; k < 8; ++k) {
            const int tk = 8 * wid + k; const int j = lane; const float mine = IMP[tk * 64 + j];
            int cnt = 0;
            for (int jj = 1; jj <= qt - 2; ++jj) { const float v = IMP[tk * 64 + jj]; cnt += ((v > mine) || (v == mine && jj < j)) ? 1 : 0; }
            const bool sel = (j >= 1 && j <= qt - 2 && cnt < 13) || j == 0 || j == qt - 1 || j == qt;
            const unsigned long long mk = __ballot(sel);
            if (lane == 0) SEL[tk] = mk;
        }
    }
    __syncthreads();
    const unsigned long long mysel = SEL[ti];
    unsigned long long wsel = mysel;
#pragma unroll
    for (int o = 4; o < 32; o <<= 1) wsel |= __shfl_xor(wsel, o);
    wsel = __builtin_amdgcn_readfirstlane((unsigned)wsel) | ((unsigned long long)__builtin_amdgcn_readfirstlane((unsigned)(wsel >> 32)) << 32);

#define KV_LOAD(KOFF, VTp, j) do { kreg = *(const u32x4*)(Zb + (size_t)((j) * 64 + srow) * LDZ + (KOFF) + g * 64 + sch * 8); vreg = *(const u32x4*)((VTp) + (size_t)srow * SEQ + (j) * 64 + sch * 8); } while (0)
    {
        m = NEGF; l = 0.f; o0 = (f32x16){}; o1 = (f32x16){};
        const int j0 = qt >= 8 ? qt - 8 : 0, nj = qt - j0 + 1;
        KV_LOAD(ZKW, VTw, j0); ST_STORE(0); __syncthreads();
        for (int i = 0; i < nj; ++i) {
            const int j = j0 + i;
            if (i + 1 < nj) KV_LOAD(ZKW, VTw, j + 1);
            const int lo = (j == qt - 8) ? ti + 1 : 0, hi = (j == qt) ? ti : 63;
            attn_tile<2>(lds + AL_K + (i & 1) * 9216, lds + AL_V + (i & 1) * 9216, qr, lo, hi, m, l, 0.f, o0, o1, nullptr, lane);
            if (i + 1 < nj) ST_STORE((i + 1) & 1);
            __syncthreads();
        }
        const float lt = l + __shfl_xor(l, 32);
        const float sc = lt > 0.f ? g2 / lt : 0.f;
        out0 += o0 * sc; out1 += o1 * sc;
    }
    {
        m = NEGF; l = 0.f; o0 = (f32x16){}; o1 = (f32x16){};
        const int nj = qt + 1;
        KV_LOAD(ZKS, VTs, 0); ST_STORE(0); __syncthreads();
        for (int j = 0; j < nj; ++j) {
            if (j + 1 < nj) KV_LOAD(ZKS, VTs, j + 1);
            if ((wsel >> j) & 1ull) {
                const int hi = ((mysel >> j) & 1ull) ? ((j == qt) ? ti : 63) : -1;
                attn_tile<2>(lds + AL_K + (j & 1) * 9216, lds + AL_V + (j & 1) * 9216, qr, 0, hi, m, l, 0.f, o0, o1, nullptr, lane);
            }
            if (j + 1 < nj) ST_STORE((j + 1) & 1);
            __syncthreads();
        }
        const float lt = l + __shfl_xor(l, 32);
        const float sc = lt > 0.f ? g1 / lt : 0.f;
        out0 += o0 * sc; out1 += o1 * sc;
    }
#pragma unroll
    for (int rg = 0; rg < 4; ++rg) {
        u32x2 w0; w0.x = pk2(out0[4 * rg], out0[4 * rg + 1]); w0.y = pk2(out0[4 * rg + 2], out0[4 * rg + 3]);
        *(u32x2*)(qrow + 8 * rg + 4 * hh) = w0;
        u32x2 w1; w1.x = pk2(out1[4 * rg], out1[4 * rg + 1]); w1.y = pk2(out1[4 * rg + 2], out1[4 * rg + 3]);
        *(u32x2*)(qrow + 32 + 8 * rg + 4 * hh) = w1;
    }
#undef ST_STORE
#undef CMP_LOAD
#undef KV_LOAD
}

__global__ void __launch_bounds__(NTHREADS, 2) nsa_fwd(Args a_unused) {
    extern __shared__ __attribute__((aligned(16))) unsigned char lds[];
    cg::grid_group grid = cg::this_grid();
    const int G = gridDim.x, bid = blockIdx.x;
    const int wave_s = __builtin_amdgcn_readfirstlane(threadIdx.x >> 6);
#define TIDS() const int tid = tid_now(wave_s), lane = tid & 63, wave = __builtin_amdgcn_readfirstlane(tid >> 6), gw = bid * 8 + wave, ngw = G * 8; (void)lane; (void)gw; (void)ngw
    PG8_LAS unsigned char* lds3 = (PG8_LAS unsigned char*)lds;
#define ZP(a) ((bf16_t*)((a).ws + WS_Z))
#define XBP(a) ((bf16_t*)((a).ws + WS_XB))
#define SSQP(a) ((float*)((a).ws + WS_SSQ))
#define WP(a) ((a).ws + WS_W)
#pragma unroll 1
    for (int l = 0; l < DEPTH; ++l) {
        { TIDS(); const Args a = load_args(); phase_weights(a, l, lds, gw, ngw, wave, lane); }
        if (l == 0) { TIDS(); const Args a = load_args(); phase_x0(a, gw, ngw, lane); }
        grid.sync();
        {
            const Args a = load_args();
            pg8::Gemm gm{XBP(a), (const bf16_t*)(WP(a) + W_IN), TOK, NIN, DM, DM}; pg8::StaticOrder S; S.init(TOK, NIN, G, bid);
            fill_rtab(S, SSQP(a) + (size_t)(2 * l) * TOK * 16, (float*)(lds + RTAB_OFF), tid_now(wave_s));
            EpiIn E{ZP(a), (float*)(a.ws + WS_GN), (const float*)(lds + RTAB_OFF), 0};
            pg8::gemm_phase<EpiIn, pg8::StaticOrder, true, true>(lds3, gm, S, E, tid_now(wave_s));
        }
        grid.sync();
        { TIDS(); const Args a = load_args(); for (int it = bid; it < 1024; it += G) vt_item(a, it, lds, tid); }
        { TIDS(); const Args a = load_args(); for (int it = bid; it < 256; it += G) cmp_item(a, l, it, lds, tid); }
        { TIDS(); const Args a = load_args(); for (int it = bid; it < 4096; it += G) rnn_item<1>(a, l, it, lds, tid); }
        grid.sync();
        { TIDS(); const Args a = load_args(); for (int it = bid; it < 4096; it += G) rnn_item<2>(a, l, it, lds, tid); }
        {
            TIDS(); const Args a = load_args();
#pragma unroll 1
            for (int u = bid * 2; u < 512; u += G * 2) {
#pragma unroll 1
                for (int h2 = 0; h2 < 2; ++h2) {
                    const int bg = u >> 6, s = (u & 63) >> 1;
                    attn_unit(a, bg >> 1, bg & 1, h2 ? s : 63 - s, lds, tid);
                }
            }
        }
        grid.sync();
        {
            const Args a = load_args();
            pg8::Gemm gm{ZP(a) + ZQ, (const bf16_t*)(WP(a) + W_UPA), TOK, DM, 512, LDZ}; pg8::StaticOrder S; S.init(TOK, DM, G, bid);
            EpiUp<0> E{ZP(a)};
            pg8::gemm_phase<EpiUp<0>, pg8::StaticOrder, true, true>(lds3, gm, S, E, tid_now(wave_s));
        }
        {
            const Args a = load_args();
            pg8::Gemm gm{ZP(a) + ZGR, (const bf16_t*)(WP(a) + W_UPR), TOK, DM, DM, LDZ}; pg8::StaticOrder S; S.init(TOK, DM, G, bid);
            EpiUp<1> E{ZP(a)};
            pg8::gemm_phase<EpiUp<1>, pg8::StaticOrder, true, true>(lds3, gm, S, E, tid_now(wave_s));
        }
        grid.sync();
        {
            const Args a = load_args();
            pg8::Gemm gm{ZP(a) + ZXR, (const bf16_t*)(WP(a) + W_OUT), TOK, DM, DM, LDZ}; pg8::StaticOrder S; S.init(TOK, DM, G, bid);
            EpiRes E{a.out, XBP(a), SSQP(a) + (size_t)(2 * l + 1) * TOK * 16};
            pg8::gemm_phase<EpiRes, pg8::StaticOrder, true, true>(lds3, gm, S, E, tid_now(wave_s));
        }
        grid.sync();
        {
            const Args a = load_args();
            pg8::Gemm gm{XBP(a), (const bf16_t*)(WP(a) + W_1), TOK, DFF, DM, DM}; pg8::StaticOrder S; S.init(TOK, DFF, G, bid);
            fill_rtab(S, SSQP(a) + (size_t)(2 * l + 1) * TOK * 16, (float*)(lds + RTAB_OFF), tid_now(wave_s));
            EpiMlpUp E{ZP(a), (const float*)(lds + RTAB_OFF), 0};
            pg8::gemm_phase<EpiMlpUp, pg8::StaticOrder, true, true>(lds3, gm, S, E, tid_now(wave_s));
        }
        grid.sync();
        {
            const Args a = load_args();
            pg8::Gemm gm{ZP(a), (const bf16_t*)(WP(a) + W_2), TOK, DM, DFF, DFF}; pg8::StaticOrder S; S.init(TOK, DM, G, bid);
            EpiRes E{a.out, XBP(a), SSQP(a) + (size_t)(2 * l + 2) * TOK * 16};
            pg8::gemm_phase<EpiRes, pg8::StaticOrder, true, true>(lds3, gm, S, E, tid_now(wave_s));
        }
        grid.sync();
    }
    { TIDS(); const Args a = load_args(); phase_final(a, gw, ngw, lane); }
}

extern "C" void kernel_launch(void* const* d_in, const int* in_sizes, int n_in, void* d_out, int out_size, void* d_ws, size_t ws_size, hipStream_t stream) {
    static int grid = 0;
    if (grid == 0) {
        int dev = 0, cus = 0, per_cu = 0;
        hipGetDevice(&dev);
        hipDeviceGetAttribute(&cus, hipDeviceAttributeMultiprocessorCount, dev);
        hipFuncSetAttribute((const void*)nsa_fwd, hipFuncAttributeMaxDynamicSharedMemorySize, LDS_BYTES);
        hipOccupancyMaxActiveBlocksPerMultiprocessor(&per_cu, (const void*)nsa_fwd, NTHREADS, LDS_BYTES);
        if (per_cu < 1) per_cu = 1;
        grid = cus * per_cu;
        if (n_in != 23 || ws_size < WS_END) fprintf(stderr, "kernel_launch: unexpected n_in %d / ws %zu\n", n_in, ws_size);
        fprintf(stderr, "kernel_launch: grid %d (cus %d x %d)\n", grid, cus, per_cu);
    }
    Args a{};
    for (int i = 0; i < 23; ++i) a.in[i] = (const float*)d_in[i];
    a.out = (float*)d_out; a.ws = (unsigned char*)d_ws;
    void* args[] = {&a};
    hipError_t e = hipLaunchCooperativeKernel((const void*)nsa_fwd, dim3(grid), dim3(NTHREADS), args, LDS_BYTES, stream);
    if (e != hipSuccess) fprintf(stderr, "cooperative launch failed: %s (grid %d)\n", hipGetErrorString(e), grid);
}
```

```cpp
#include <hip/hip_runtime.h>
#include <hip/hip_cooperative_groups.h>
#include <cstdio>
#include <cstdint>
namespace cg = cooperative_groups;
namespace pg8 {
#define PG8_LAS __attribute__((address_space(3)))
typedef unsigned short bf16_t;
typedef short bf16x8 __attribute__((ext_vector_type(8)));
typedef float f32x4 __attribute__((ext_vector_type(4)));
typedef unsigned u32x4 __attribute__((ext_vector_type(4)));
constexpr int BM = 256, BK = 64, HALF = 128, HTB = HALF * BK * 2  , STAGE_BYTES = 8 * HTB, NXCD = 8, WGM = 8;

__host__ __device__ __forceinline__ int lds_byte(int r, int c) { const int st = (r >> 4) * 2 + (c >> 5), rr = r & 15, cc = c & 31, ob = rr * 64 + cc * 2; return st * 1024 + (ob ^ (((ob >> 9) & 1) << 5)); }
__host__ __device__ __forceinline__ void stage_rc(int b, int& R, int& C) { const int st = b / 1024, sb = b % 1024, swz = sb ^ (((sb >> 9) & 1) << 5); R = (st >> 1) * 16 + swz / 64; C = (st & 1) * 32 + (swz % 64) / 2; }
__host__ __device__ __forceinline__ int perm32(int rho) { const int n = rho >> 4, i = rho & 15; return 8 * (i >> 2) + 4 * n + (i & 3); }

struct Unit { int pm, pn; };
struct Gemm { const bf16_t* A; const bf16_t* Bt; int M, N, K, lda; };

struct StaticOrder {
    int nM, nN, nwg, G, c;
    __host__ __device__ void init(int M, int N, int G_, int c_) { nM = M / BM; nN = N / BM; nwg = nM * nN; G = G_; c = c_; }
    __host__ __device__ bool next(int i, Unit& u) const {
        const long L = (long)i * G + c; if (L >= nwg) return false;
        int wgid = (int)L; { const int q = nwg / NXCD, r = nwg % NXCD, xcd = wgid % NXCD, off = wgid / NXCD; wgid = (xcd < r ? xcd * (q + 1) : r * (q + 1) + (xcd - r) * q) + off; }
        const int nig = WGM * nN, gid = wgid / nig, fm = gid * WGM, gsz = (nM - fm) < WGM ? (nM - fm) : WGM;
        u.pm = fm + ((wgid % nig) % gsz); u.pn = (wgid % nig) / gsz; return true;
    }
    __device__ __forceinline__ void a_ready(const Unit&) const {}
    __device__ __forceinline__ void done(const Unit&) const {}
};

__device__ __forceinline__ unsigned cvt_pk_bf16(float lo, float hi) { unsigned r; asm volatile("v_cvt_pk_bf16_f32 %0, %1, %2" : "=v"(r) : "v"(lo), "v"(hi)); return r; }
typedef float f32x2 __attribute__((ext_vector_type(2)));
template <class Epi, class Sched, bool ALIGN_EPI = false, bool SP2 = false>
__device__ __forceinline__ void gemm_phase(PG8_LAS unsigned char* lds, const Gemm g, const Sched& S, const Epi& E, int tid_in) {
    int tid_ = tid_in; asm volatile("" : "+v"(tid_)); const int tid = tid_, wid = __builtin_amdgcn_readfirstlane(tid >> 6), lane = tid & 63, wr = wid >> 2, wc = wid & 3, fr = lane & 15, fq = lane >> 4;
    const int K = g.K, nt = K / BK;
    unsigned voffA[2], voffB[2];
#pragma unroll
    for (int i = 0; i < 2; ++i) { int R, C; stage_rc(tid * 16 + i * 8192, R, C); const int Rb = Epi::PERM ? ((R & ~31) + perm32(R & 31)) : R;
        voffA[i] = (unsigned)(R * g.lda + C) * 2u; voffB[i] = (unsigned)(Rb * K + C) * 2u; }
    const size_t kstep = (size_t)(BK * 2);
    const size_t hstep = (size_t)HALF * K * 2;
    const size_t tstep = 2 * hstep; const size_t hstepA = (size_t)HALF * g.lda * 2, tstepA = 2 * hstepA;
    const unsigned ldsw = (unsigned)wid * 1024u;
    const int aoff = lds_byte(wr * 64 + fr, fq * 8), boff = lds_byte(wc * 32 + fr, fq * 8);
#define PG8_SA(b, h) (((b) * 2 + (h)) * HTB)
#define PG8_SB(b, h) ((4 + (b) * 2 + (h)) * HTB)
#define PG8_STAGE(bufoff, gbase, voff) do { _Pragma("unroll") for (int _i = 0; _i < 2; ++_i) \
        __builtin_amdgcn_global_load_lds((const unsigned*)((const char*)(gbase) + (voff)[_i]), (PG8_LAS unsigned*)(lds + (bufoff) + ldsw + _i * 8192), 16, 0, 0); } while (0)
#define PG8_LDA(dst, b, h) do { _Pragma("unroll") for (int m = 0; m < 4; ++m) _Pragma("unroll") for (int k = 0; k < 2; ++k) dst[m][k] = *(const PG8_LAS bf16x8*)(lds + PG8_SA(b, h) + aoff + m * 2048 + k * 1024); } while (0)
#define PG8_LDB(dst, b, h) do { _Pragma("unroll") for (int n = 0; n < 2; ++n) _Pragma("unroll") for (int k = 0; k < 2; ++k) dst[n][k] = *(const PG8_LAS bf16x8*)(lds + PG8_SB(b, h) + boff + n * 2048 + k * 1024); } while (0)
#define PG8_MMA(ai, bj, At, Bt) do { __builtin_amdgcn_s_setprio(1); _Pragma("unroll") for (int m = 0; m < 4; ++m) _Pragma("unroll") for (int n = 0; n < 2; ++n) _Pragma("unroll") for (int k = 0; k < 2; ++k) \
        acc[ai][bj][m][n] = __builtin_amdgcn_mfma_f32_16x16x32_bf16(Bt[n][k], At[m][k], acc[ai][bj][m][n], 0, 0, 0); __builtin_amdgcn_s_setprio(0); } while (0)
#define PG8_WAIT_V(n) asm volatile("s_waitcnt vmcnt(" #n ")" ::: "memory")
#define PG8_WAIT_L(n) asm volatile("s_waitcnt lgkmcnt(" #n ")" ::: "memory")
#define PG8_BAR __builtin_amdgcn_s_barrier()
#define PG8_SCHED __builtin_amdgcn_sched_barrier(0)
    Unit cur, nxt; int ui = 0;
    if (!S.next(0, cur)) return;
    f32x4 acc[2][2][4][2];
#pragma unroll
    for (int a = 0; a < 2; ++a)
#pragma unroll
        for (int b = 0; b < 2; ++b)
#pragma unroll
            for (int m = 0; m < 4; ++m)
#pragma unroll
                for (int n = 0; n < 2; ++n) acc[a][b][m][n] = (f32x4){0.f, 0.f, 0.f, 0.f};
    bf16x8 At[4][2], B0[2][2], B1[2][2];
    const char* cA = (const char*)g.A + (size_t)cur.pm * tstepA; const char* cB = (const char*)g.Bt + (size_t)cur.pn * tstep;
    S.a_ready(cur);
    if constexpr (SP2) {
        PG8_STAGE(PG8_SB(0, 0), cB, voffB); PG8_STAGE(PG8_SB(0, 1), cB + hstep, voffB); PG8_STAGE(PG8_SA(0, 0), cA, voffA); PG8_STAGE(PG8_SA(0, 1), cA + hstepA, voffA);
        if (wr == 1) PG8_BAR;
        PG8_WAIT_V(2); PG8_BAR;
        PG8_STAGE(PG8_SB(1, 0), cB + kstep, voffB); PG8_STAGE(PG8_SA(1, 0), cA + kstep, voffA); PG8_STAGE(PG8_SB(1, 1), cB + hstep + kstep, voffB);
        PG8_WAIT_V(6); PG8_BAR;
    } else {
        PG8_STAGE(PG8_SB(0, 0), cB, voffB); PG8_STAGE(PG8_SA(0, 0), cA, voffA); PG8_STAGE(PG8_SB(0, 1), cB + hstep, voffB); PG8_STAGE(PG8_SA(0, 1), cA + hstepA, voffA);
        if (wr == 1) PG8_BAR;
        PG8_WAIT_V(4); PG8_BAR;
        PG8_STAGE(PG8_SB(1, 0), cB + kstep, voffB); PG8_STAGE(PG8_SA(1, 0), cA + kstep, voffA); PG8_STAGE(PG8_SB(1, 1), cB + hstep + kstep, voffB);
        PG8_WAIT_V(6); PG8_BAR;
    }
    for (;;) {
        const bool has_next = S.next(ui + 1, nxt);
        const char* nA = has_next ? (const char*)g.A + (size_t)nxt.pm * tstepA : cA; const char* nB = has_next ? (const char*)g.Bt + (size_t)nxt.pn * tstep : cB;
        for (int t = 0; t < nt; t += 2) {
            const bool last = (t == nt - 2);
            const char* a1 = cA + (size_t)(t + 1) * kstep;
            const char* a2 = last ? nA : cA + (size_t)(t + 2) * kstep; const char* b2 = last ? nB : cB + (size_t)(t + 2) * kstep;
            const char* a3 = a2 + kstep; const char* b3 = b2 + kstep;
            if (last && has_next) S.a_ready(nxt);
            if constexpr (SP2) {
            PG8_LDB(B0, 0, 0); PG8_LDB(B1, 0, 1); PG8_SCHED; PG8_LDA(At, 0, 0); PG8_STAGE(PG8_SA(1, 1), a1 + hstepA, voffA);
            PG8_WAIT_V(8); PG8_WAIT_L(0); PG8_BAR; PG8_MMA(0, 0, At, B0); PG8_MMA(0, 1, At, B1); PG8_BAR; PG8_SCHED;
            PG8_LDA(At, 0, 1); PG8_STAGE(PG8_SB(0, 0), b2, voffB); PG8_STAGE(PG8_SB(0, 1), b2 + hstep, voffB); PG8_STAGE(PG8_SA(0, 0), a2, voffA);
            PG8_WAIT_V(8); PG8_WAIT_L(0); PG8_BAR; PG8_MMA(1, 0, At, B0); PG8_MMA(1, 1, At, B1); PG8_BAR; PG8_SCHED;
            PG8_LDB(B0, 1, 0); PG8_LDB(B1, 1, 1); PG8_SCHED; PG8_LDA(At, 1, 0); PG8_STAGE(PG8_SA(0, 1), a2 + hstepA, voffA);
            PG8_WAIT_V(8); PG8_WAIT_L(0); PG8_BAR; PG8_MMA(0, 0, At, B0); PG8_MMA(0, 1, At, B1); PG8_BAR; PG8_SCHED;
            PG8_LDA(At, 1, 1); PG8_STAGE(PG8_SB(1, 0), b3, voffB); PG8_STAGE(PG8_SB(1, 1), b3 + hstep, voffB); PG8_STAGE(PG8_SA(1, 0), a3, voffA);
            PG8_WAIT_V(8); PG8_WAIT_L(0); PG8_BAR; PG8_MMA(1, 0, At, B0); PG8_MMA(1, 1, At, B1); PG8_BAR; PG8_SCHED;
            } else {
            PG8_LDB(B0, 0, 0); PG8_SCHED; PG8_LDA(At, 0, 0); PG8_STAGE(PG8_SA(1, 1), a1 + hstepA, voffA);
            PG8_WAIT_L(8); PG8_BAR; PG8_WAIT_L(0); PG8_MMA(0, 0, At, B0); PG8_BAR; PG8_SCHED;
            PG8_LDB(B1, 0, 1); PG8_STAGE(PG8_SB(0, 0), b2, voffB);
            PG8_BAR; PG8_WAIT_L(0); PG8_MMA(0, 1, At, B1); PG8_BAR;
            PG8_LDA(At, 0, 1); PG8_STAGE(PG8_SA(0, 0), a2, voffA);
            PG8_BAR; PG8_WAIT_L(0); PG8_MMA(1, 0, At, B0); PG8_BAR; PG8_SCHED;
            PG8_STAGE(PG8_SB(0, 1), b2 + hstep, voffB);
            PG8_WAIT_V(6); PG8_BAR; PG8_MMA(1, 1, At, B1); PG8_BAR;
            PG8_LDB(B0, 1, 0); PG8_SCHED; PG8_LDA(At, 1, 0); PG8_STAGE(PG8_SA(0, 1), a2 + hstepA, voffA);
            PG8_WAIT_L(8); PG8_BAR; PG8_WAIT_L(0); PG8_MMA(0, 0, At, B0); PG8_BAR; PG8_SCHED;
            PG8_LDB(B1, 1, 1); PG8_STAGE(PG8_SB(1, 0), b3, voffB);
            PG8_BAR; PG8_WAIT_L(0); PG8_MMA(0, 1, At, B1); PG8_BAR;
            PG8_LDA(At, 1, 1); PG8_STAGE(PG8_SA(1, 0), a3, voffA);
            PG8_BAR; PG8_WAIT_L(0); PG8_MMA(1, 0, At, B0); PG8_BAR; PG8_SCHED;
            PG8_STAGE(PG8_SB(1, 1), b3 + hstep, voffB);
            PG8_WAIT_V(6); PG8_BAR; PG8_MMA(1, 1, At, B1); PG8_BAR;
            }
        }
        if constexpr (ALIGN_EPI) { if (wr == 0) PG8_BAR; }
        if constexpr (!Epi::AFTER_DRAIN) { E(acc, cur, wr, wc, fr, fq); S.done(cur); }
        if (!has_next) break;
#pragma unroll
        for (int a = 0; a < 2; ++a)
#pragma unroll
            for (int b = 0; b < 2; ++b)
#pragma unroll
                for (int m = 0; m < 4; ++m)
#pragma unroll
                    for (int n = 0; n < 2; ++n) acc[a][b][m][n] = (f32x4){0.f, 0.f, 0.f, 0.f};
        cur = nxt; cA = nA; cB = nB; ++ui;
        if constexpr (ALIGN_EPI) { if (wr == 1) PG8_BAR; }
    }
    PG8_WAIT_V(0);
    if constexpr (!ALIGN_EPI) { if (wr == 0) PG8_BAR; }
    PG8_BAR;
    if constexpr (Epi::AFTER_DRAIN) { E.fused(acc, cur, wr, wc, fr, fq, lds, wid, lane); S.done(cur); }
#undef PG8_SA
#undef PG8_SB
#undef PG8_STAGE
#undef PG8_LDA
#undef PG8_LDB
#undef PG8_MMA
#undef PG8_WAIT_V
#undef PG8_WAIT_L
#undef PG8_BAR
#undef PG8_SCHED
}
}
using pg8::bf16_t; using pg8::bf16x8; using pg8::f32x4; using pg8::u32x4;
typedef float f32x16 __attribute__((ext_vector_type(16)));
typedef unsigned u32x2 __attribute__((ext_vector_type(2)));
typedef short s16x4 __attribute__((ext_vector_type(4)));

constexpr int BATCH = 4, SEQ = 4096, DM = 1024, TOK = BATCH * SEQ, DEPTH = 2, DFF = 4096;
constexpr int LDZ = 5376, NIN = 5632, DIN = 5400;
constexpr int ZQ = 0, ZKC = 512, ZVC = 640, ZKS = 768, ZVS = 896, ZKW = 1024, ZVW = 1152, ZXR = 1280, ZGR = 2304, ZGA = 3328, ZGB = 4352;
constexpr float EPSN = 1e-6f;
constexpr float QSCALE = 0.125f * 1.4426950408889634f;
constexpr int NTHREADS = 512;
#ifndef REP_P0
#define REP_P0 1
#endif
#ifndef REP_P2
#define REP_P2 1
#endif
constexpr int LDS_BYTES = 147456;

constexpr size_t MiB = 1u << 20;
constexpr size_t W_IN = 0, W_UPA = 11 * MiB, W_UPR = 12 * MiB, W_OUT = 14 * MiB, W_1 = 16 * MiB, W_2 = 24 * MiB, W_CK1 = 32 * MiB, W_CV1 = 33 * MiB,
                 W_CK2 = 34 * MiB, W_CV2 = 34 * MiB + 32768, W_A = 34 * MiB + 65536, W_I = 34 * MiB + 65536 + 131072;
constexpr size_t WS_W = 0, WS_Z = 36 * MiB, WS_XB = 204 * MiB, WS_GN = 236 * MiB, WS_SSQ = 238 * MiB, WS_KC = 243 * MiB, WS_VCT = 243 * MiB + 262144,
                 WS_VT = 244 * MiB, WS_AGG = 252 * MiB, WS_END = 254 * MiB;

struct Args { const float* in[23]; float* out; unsigned char* ws; };
typedef const __attribute__((address_space(4))) Args* ArgsP;
__device__ __forceinline__ int tid_now(int wave_s) { int t; asm volatile("v_mbcnt_lo_u32_b32 %0, -1, 0\n\tv_mbcnt_hi_u32_b32 %0, -1, %0\n\tv_lshl_add_u32 %0, %1, 6, %0" : "=&v"(t) : "s"(wave_s)); return t; }
__device__ __forceinline__ Args load_args() {
    Args r{};
#if defined(__HIP_DEVICE_COMPILE__)
    ArgsP p = (ArgsP)__builtin_amdgcn_kernarg_segment_ptr(); asm volatile("" : "+s"(p));
#pragma unroll
    for (int i = 0; i < 23; ++i) r.in[i] = p->in[i];
    r.out = p->out; r.ws = p->ws;
#endif
    return r;
}

__device__ __forceinline__ unsigned f2bf(float f) { unsigned u = __builtin_bit_cast(unsigned, f); return (u + 0x7fffu + ((u >> 16) & 1u)) >> 16; }
__device__ __forceinline__ unsigned pk2(float lo, float hi) { return pg8::cvt_pk_bf16(lo, hi); }
__device__ __forceinline__ float bf2f(unsigned short v) { return __builtin_bit_cast(float, (unsigned)v << 16); }
__device__ __forceinline__ float bflo(unsigned v) { return __builtin_bit_cast(float, v << 16); }
__device__ __forceinline__ float bfhi(unsigned v) { return __builtin_bit_cast(float, v & 0xffff0000u); }
__device__ __forceinline__ float sigmoidf_(float x) { return 1.0f / (1.0f + __expf(-x)); }
__device__ __forceinline__ float gelu_tanh(float x) {
    const float y = 0.7978845608028654f * (x + 0.044715f * x * x * x);
    const float e = __expf(2.0f * y);
    const float th = 1.0f - 2.0f / (e + 1.0f);
    return 0.5f * x * (1.0f + th);
}
__device__ __forceinline__ float wave_sum(float v) {
#pragma unroll
    for (int o = 1; o < 64; o <<= 1) v += __shfl_xor(v, o);
    return v;
}
__device__ __forceinline__ float rstd_from_ssq(const float* p) {
    const f32x4 a = *(const f32x4*)p, b = *(const f32x4*)(p + 4), c = *(const f32x4*)(p + 8), d = *(const f32x4*)(p + 12);
    const float s = ((a.x + a.y) + (a.z + a.w)) + ((b.x + b.y) + (b.z + b.w)) + ((c.x + c.y) + (c.z + c.w)) + ((d.x + d.y) + (d.z + d.w));
    return rsqrtf(s * (1.0f / 1024.0f) + EPSN);
}

struct EpiIn {
    static constexpr bool PERM = true, AFTER_DRAIN = false;
    bf16_t* Z; float* GN; const float* rtab; mutable int ui;
    __device__ __forceinline__ void operator()(const f32x4 (&acc)[2][2][4][2], const pg8::Unit& u, int wr, int wc, int fr, int fq) const {
        const int row0 = u.pm * 256 + wr * 64 + fr;
        const float* rt = rtab + ui * 256 + wr * 64 + fr; ++ui;
#pragma unroll
        for (int ai = 0; ai < 2; ++ai)
#pragma unroll
            for (int m = 0; m < 4; ++m) {
                const int row = row0 + ai * 128 + m * 16;
                const float rstd = rt[ai * 128 + m * 16];
                asm volatile("" ::: "memory");
                if (u.pn < 21) {
                    const float sc = rstd * (u.pn < 2 ? QSCALE : 1.0f);
                    bf16_t* rowp = Z + (size_t)row * LDZ + u.pn * 256 + wc * 32 + 8 * fq;
#pragma unroll
                    for (int bj = 0; bj < 2; ++bj) {
                        const f32x4 v0 = acc[ai][bj][m][0] * sc, v1 = acc[ai][bj][m][1] * sc;
                        u32x4 w; w.x = pk2(v0[0], v0[1]); w.y = pk2(v0[2], v0[3]); w.z = pk2(v1[0], v1[1]); w.w = pk2(v1[2], v1[3]);
                        *(u32x4*)(rowp + bj * 128) = w;
                    }
                } else if (wc == 0) {
                    float* gp = GN + (size_t)row * 32 + 8 * fq;
#pragma unroll
                    for (int n = 0; n < 2; ++n) {
                        const f32x4 v = acc[ai][0][m][n] * rstd;
                        f32x4 o; o.x = sigmoidf_(v.x); o.y = sigmoidf_(v.y); o.z = sigmoidf_(v.z); o.w = sigmoidf_(v.w);
                        *(f32x4*)(gp + 4 * n) = o;
                    }
                }
            }
    }
};
template <int MODE>
struct EpiUp {
    static constexpr bool PERM = true, AFTER_DRAIN = false;
    bf16_t* Z;
    __device__ __forceinline__ void operator()(const f32x4 (&acc)[2][2][4][2], const pg8::Unit& u, int wr, int wc, int fr, int fq) const {
        const int row0 = u.pm * 256 + wr * 64 + fr;
        const int col0 = u.pn * 256 + wc * 32 + 8 * fq;
#pragma unroll
        for (int ai = 0; ai < 2; ++ai)
#pragma unroll
            for (int m = 0; m < 4; ++m) {
                bf16_t* rowp = Z + (size_t)(row0 + ai * 128 + m * 16) * LDZ + col0;
                asm volatile("" ::: "memory");
#pragma unroll
                for (int bj = 0; bj < 2; ++bj) {
                    const u32x4 gg = *(const u32x4*)(rowp + (MODE == 0 ? ZGA : ZGB) + bj * 128);
                    float g[8] = {bflo(gg.x), bfhi(gg.x), bflo(gg.y), bfhi(gg.y), bflo(gg.z), bfhi(gg.z), bflo(gg.w), bfhi(gg.w)};
                    float v[8];
#pragma unroll
                    for (int e = 0; e < 4; ++e) { v[e] = sigmoidf_(g[e]) * acc[ai][bj][m][0][e]; v[4 + e] = sigmoidf_(g[4 + e]) * acc[ai][bj][m][1][e]; }
                    if (MODE == 1) {
                        const u32x4 tt = *(const u32x4*)(rowp + ZXR + bj * 128);
                        v[0] += bflo(tt.x); v[1] += bfhi(tt.x); v[2] += bflo(tt.y); v[3] += bfhi(tt.y); v[4] += bflo(tt.z); v[5] += bfhi(tt.z); v[6] += bflo(tt.w); v[7] += bfhi(tt.w);
                    }
                    u32x4 w; w.x = pk2(v[0], v[1]); w.y = pk2(v[2], v[3]); w.z = pk2(v[4], v[5]); w.w = pk2(v[6], v[7]);
                    *(u32x4*)(rowp + ZXR + bj * 128) = w;
                }
            }
    }
};
struct EpiRes {
    static constexpr bool PERM = false, AFTER_DRAIN = false;
    float* X; bf16_t* XB; float* ssq;
    __device__ __forceinline__ void operator()(const f32x4 (&acc)[2][2][4][2], const pg8::Unit& u, int wr, int wc, int fr, int fq) const {
        const int row0 = u.pm * 256 + wr * 64 + fr;
        const int col0 = u.pn * 256 + wc * 32 + 4 * fq;
#pragma unroll
        for (int ai = 0; ai < 2; ++ai)
#pragma unroll
            for (int m = 0; m < 4; ++m) {
                const int row = row0 + ai * 128 + m * 16;
                float ss = 0.f;
                asm volatile("" ::: "memory");
#pragma unroll
                for (int bj = 0; bj < 2; ++bj)
#pragma unroll
                    for (int n = 0; n < 2; ++n) {
                        const size_t off = (size_t)row * DM + col0 + bj * 128 + n * 16;
                        f32x4 v = *(const f32x4*)(X + off) + acc[ai][bj][m][n];
                        *(f32x4*)(X + off) = v;
                        u32x2 w; w.x = pk2(v.x, v.y); w.y = pk2(v.z, v.w);
                        *(u32x2*)(XB + off) = w;
                        ss += (v.x * v.x + v.y * v.y) + (v.z * v.z + v.w * v.w);
                    }
                ss += __shfl_xor(ss, 16); ss += __shfl_xor(ss, 32);
                if (fq == 0) ssq[(size_t)row * 16 + u.pn * 4 + wc] = ss;
            }
    }
};
struct EpiMlpUp {
    static constexpr bool PERM = true, AFTER_DRAIN = false;
    bf16_t* H; const float* rtab; mutable int ui;
    __device__ __forceinline__ void operator()(const f32x4 (&acc)[2][2][4][2], const pg8::Unit& u, int wr, int wc, int fr, int fq) const {
        const int row0 = u.pm * 256 + wr * 64 + fr;
        const int col0 = u.pn * 256 + wc * 32 + 8 * fq;
        const float* rt = rtab + ui * 256 + wr * 64 + fr; ++ui;
#pragma unroll
        for (int ai = 0; ai < 2; ++ai)
#pragma unroll
            for (int m = 0; m < 4; ++m) {
                const int row = row0 + ai * 128 + m * 16;
                const float rstd = rt[ai * 128 + m * 16];
                asm volatile("" ::: "memory");
                bf16_t* rowp = H + (size_t)row * DFF + col0;
#pragma unroll
                for (int bj = 0; bj < 2; ++bj) {
                    f32x4 v0 = acc[ai][bj][m][0] * rstd, v1 = acc[ai][bj][m][1] * rstd;
#pragma unroll
                    for (int e = 0; e < 4; ++e) { const float a = fmaxf(v0[e], 0.f), b = fmaxf(v1[e], 0.f); v0[e] = a * a; v1[e] = b * b; }
                    u32x4 w; w.x = pk2(v0[0], v0[1]); w.y = pk2(v0[2], v0[3]); w.z = pk2(v1[0], v1[1]); w.w = pk2(v1[2], v1[3]);
                    *(u32x4*)(rowp + bj * 128) = w;
                }
            }
    }
};

constexpr int RTAB_OFF = 131072;
__device__ __forceinline__ void fill_rtab(const pg8::StaticOrder& S, const float* ssq, float* tab, int tid) {
    pg8::Unit u;
    for (int i = 0; S.next(i, u); ++i)
        if (tid < 256) tab[i * 256 + tid] = rstd_from_ssq(ssq + (size_t)(u.pm * 256 + tid) * 16);
    __syncthreads();
}
__device__ __forceinline__ void tr_item(const float* W, int ldn, int k0, int src_n0, int nvalid, const float* ks, bf16_t* dst, int dstK, int dst_row0, float* scr, int lane) {
    const int n = lane & 31;
#pragma unroll 8
    for (int i = 0; i < 32; ++i) {
        const int kk = 2 * i + (lane >> 5);
        float v = (n < nvalid) ? W[(size_t)(k0 + kk) * ldn + src_n0 + n] : 0.f;
        if (ks) v *= ks[k0 + kk];
        scr[kk * 33 + n] = v;
    }
    asm volatile("s_waitcnt lgkmcnt(0)" ::: "memory");
    const int c = lane & 7;
#pragma unroll
    for (int j = 0; j < 4; ++j) {
        const int nn = (lane >> 3) + 8 * j; const float* s = scr + (8 * c) * 33 + nn;
        u32x4 o; o.x = pk2(s[0 * 33], s[1 * 33]); o.y = pk2(s[2 * 33], s[3 * 33]); o.z = pk2(s[4 * 33], s[5 * 33]); o.w = pk2(s[6 * 33], s[7 * 33]);
        *(u32x4*)(dst + (size_t)(dst_row0 + nn) * dstK + k0 + 8 * c) = o;
    }
    asm volatile("s_waitcnt lgkmcnt(0)" ::: "memory");
}

__device__ __forceinline__ void phase_weights(const Args& a, int l, unsigned char* lds, int gw, int ngw, int wave, int lane) {
    float* scr = (float*)(lds + wave * 16384);
    unsigned char* W = a.ws + WS_W;
    constexpr int I_IN = 16 * 176, I_UPA = 8 * 32, I_UPR = 16 * 32, I_OUT = 16 * 32, I_1 = 16 * 128, I_2 = 64 * 32, I_C1 = 32 * 8, I_C2 = 4 * 2, I_L = 16 * 2;
    constexpr int NITEMS = I_IN + I_UPA + I_UPR + I_OUT + I_1 + I_2 + 2 * I_C1 + 2 * I_C2 + 2 * I_L;
    for (int it = gw; it < NITEMS; it += ngw) {
        int r = it;
        if (r < I_IN) {
            const int kb = r / 176, nb = r % 176, n0 = nb * 32;
            int src, nv;
            if (n0 < 1280) { src = n0; nv = 32; } else if (n0 < 5376) { src = n0 + 24; nv = 32; } else if (n0 == 5376) { src = 1280; nv = 24; } else { src = 0; nv = 0; }
            tr_item(a.in[2] + (size_t)l * DM * DIN, DIN, kb * 64, src, nv, a.in[1] + l * DM, (bf16_t*)(W + W_IN), 1024, n0, scr, lane); continue;
        }
        r -= I_IN;
        if (r < I_UPA) { tr_item(a.in[16] + (size_t)l * 512 * 1024, 1024, (r / 32) * 64, (r % 32) * 32, 32, nullptr, (bf16_t*)(W + W_UPA), 512, (r % 32) * 32, scr, lane); continue; }
        r -= I_UPA;
        if (r < I_UPR) { tr_item(a.in[17] + (size_t)l * 1024 * 1024, 1024, (r / 32) * 64, (r % 32) * 32, 32, nullptr, (bf16_t*)(W + W_UPR), 1024, (r % 32) * 32, scr, lane); continue; }
        r -= I_UPR;
        if (r < I_OUT) { tr_item(a.in[18] + (size_t)l * 1024 * 1024, 1024, (r / 32) * 64, (r % 32) * 32, 32, nullptr, (bf16_t*)(W + W_OUT), 1024, (r % 32) * 32, scr, lane); continue; }
        r -= I_OUT;
        if (r < I_1) { tr_item(a.in[20] + (size_t)l * 1024 * 4096, 4096, (r / 128) * 64, (r % 128) * 32, 32, a.in[19] + l * DM, (bf16_t*)(W + W_1), 1024, (r % 128) * 32, scr, lane); continue; }
        r -= I_1;
        if (r < I_2) { tr_item(a.in[21] + (size_t)l * 4096 * 1024, 1024, (r / 32) * 64, (r % 32) * 32, 32, nullptr, (bf16_t*)(W + W_2), 4096, (r % 32) * 32, scr, lane); continue; }
        r -= I_2;
        if (r < I_C1) { tr_item(a.in[5] + (size_t)l * 2048 * 256, 256, (r / 8) * 64, (r % 8) * 32, 32, nullptr, (bf16_t*)(W + W_CK1), 2048, (r % 8) * 32, scr, lane); continue; }
        r -= I_C1;
        if (r < I_C1) { tr_item(a.in[7] + (size_t)l * 2048 * 256, 256, (r / 8) * 64, (r % 8) * 32, 32, nullptr, (bf16_t*)(W + W_CV1), 2048, (r % 8) * 32, scr, lane); continue; }
        r -= I_C1;
        if (r < I_C2) { tr_item(a.in[6] + (size_t)l * 256 * 64, 64, (r / 2) * 64, (r % 2) * 32, 32, nullptr, (bf16_t*)(W + W_CK2), 256, (r % 2) * 32, scr, lane); continue; }
        r -= I_C2;
        if (r < I_C2) { tr_item(a.in[8] + (size_t)l * 256 * 64, 64, (r / 2) * 64, (r % 2) * 32, 32, nullptr, (bf16_t*)(W + W_CV2), 256, (r % 2) * 32, scr, lane); continue; }
        r -= I_C2;
        if (r < I_L) { const int h = r / 2; tr_item(a.in[11] + (size_t)l * 65536 + h * 4096, 64, 0, (r % 2) * 32, 32, nullptr, (bf16_t*)(W + W_A) + h * 4096, 64, (r % 2) * 32, scr, lane); continue; }
        r -= I_L;
        { const int h = r / 2; tr_item(a.in[13] + (size_t)l * 65536 + h * 4096, 64, 0, (r % 2) * 32, 32, nullptr, (bf16_t*)(W + W_I) + h * 4096, 64, (r % 2) * 32, scr, lane); }
    }
}

__device__ __forceinline__ void phase_x0(const Args& a, int gw, int ngw, int lane) {
    const float* x = a.in[0]; float* X = a.out; bf16_t* XB = (bf16_t*)(a.ws + WS_XB); float* ssq = (float*)(a.ws + WS_SSQ);
    for (int row = gw; row < TOK; row += ngw) {
        const f32x4* xr = (const f32x4*)(x + (size_t)row * DM) + lane;
        f32x4 v[4]; float s = 0.f;
#pragma unroll
        for (int j = 0; j < 4; ++j) { v[j] = xr[64 * j]; s += (v[j].x * v[j].x + v[j].y * v[j].y) + (v[j].z * v[j].z + v[j].w * v[j].w); }
        s = wave_sum(s);
        f32x4* xo = (f32x4*)(X + (size_t)row * DM) + lane;
        u32x2* bo = (u32x2*)(XB + (size_t)row * DM) + lane;
#pragma unroll
        for (int j = 0; j < 4; ++j) { xo[64 * j] = v[j]; u32x2 w; w.x = pk2(v[j].x, v[j].y); w.y = pk2(v[j].z, v[j].w); bo[64 * j] = w; }
        if (lane < 16) ssq[(size_t)row * 16 + lane] = (lane == 0) ? s : 0.f;
    }
}
__device__ __forceinline__ void phase_final(const Args& a, int gw, int ngw, int lane) {
    float* X = a.out; const float* ssq = (const float*)(a.ws + WS_SSQ) + (size_t)4 * TOK * 16; const float* w = a.in[22];
    f32x4 wv[4];
#pragma unroll
    for (int j = 0; j < 4; ++j) wv[j] = ((const f32x4*)w)[lane + 64 * j];
    for (int row = gw; row < TOK; row += ngw) {
        const float rstd = rstd_from_ssq(ssq + (size_t)row * 16);
        f32x4* xo = (f32x4*)(X + (size_t)row * DM) + lane;
#pragma unroll
        for (int j = 0; j < 4; ++j) { f32x4 v = xo[64 * j]; v = v * rstd * wv[j]; xo[64 * j] = v; }
    }
}

__device__ __forceinline__ void vt_item(const Args& a, int item, unsigned char* lds, int tid) {
    const int tb = item & 63, g = (item >> 6) & 1, kind = (item >> 7) & 1, b = item >> 8;
    const bf16_t* Z = (const bf16_t*)(a.ws + WS_Z); bf16_t* VT = (bf16_t*)(a.ws + WS_VT);
    bf16_t* T = (bf16_t*)lds;
    const int row = tid >> 3, ch = tid & 7;
    const u32x4 v = *(const u32x4*)(Z + (size_t)(b * SEQ + tb * 64 + row) * LDZ + (kind ? ZVW : ZVS) + g * 64 + ch * 8);
    const unsigned vv[4] = {v.x, v.y, v.z, v.w};
#pragma unroll
    for (int e = 0; e < 4; ++e) { T[(ch * 8 + 2 * e) * 72 + row] = (bf16_t)(vv[e] & 0xffffu); T[(ch * 8 + 2 * e + 1) * 72 + row] = (bf16_t)(vv[e] >> 16); }
    __syncthreads();
    const u32x4 o = *(const u32x4*)(T + row * 72 + ch * 8);
    *(u32x4*)(VT + ((size_t)((b * 2 + kind) * 2 + g) * 64 + row) * SEQ + tb * 64 + ch * 8) = o;
    __syncthreads();
}

__device__ __forceinline__ void cmp_item(const Args& a, int l, int item, unsigned char* lds, int tid) {
    const int wid = tid >> 6, lane = tid & 63, fr = lane & 15, fq = lane >> 4;
    const int nct = item & 15, g = (item >> 4) & 1, b = (item >> 5) & 3, kv = item >> 7;
    const int nc0 = nct * 16;
    const bf16_t* Z = (const bf16_t*)(a.ws + WS_Z);
    const bf16_t* W1 = (const bf16_t*)(a.ws + WS_W + (kv ? W_CV1 : W_CK1));
    const bf16_t* W2 = (const bf16_t*)(a.ws + WS_W + (kv ? W_CV2 : W_CK2));
    const float* pos = (kv ? a.in[4] : a.in[3]) + (size_t)l * 2048;
    bf16_t* hid = (bf16_t*)lds;
    const int nc = nc0 + fr; const bool rowok = nc < 255;
    const bf16_t* arow = Z + (size_t)(b * SEQ + 16 * (rowok ? nc : 0)) * LDZ + (kv ? ZVC : ZKC) + g * 64;
    const bf16_t* b0 = W1 + (size_t)(32 * wid + fr) * 2048 + 8 * fq;
    const bf16_t* b1 = b0 + (size_t)16 * 2048;
    f32x4 acc0 = {0.f, 0.f, 0.f, 0.f}, acc1 = {0.f, 0.f, 0.f, 0.f};
#pragma unroll 4
    for (int ks = 0; ks < 64; ++ks) {
        const int i = ks >> 1, d = (ks & 1) * 32 + 8 * fq;
        const u32x4 av = *(const u32x4*)(arow + (size_t)i * LDZ + d);
        const f32x4 p0 = *(const f32x4*)(pos + i * 64 + d), p1 = *(const f32x4*)(pos + i * 64 + d + 4);
        u32x4 aw;
        aw.x = pk2(bflo(av.x) + p0.x, bfhi(av.x) + p0.y); aw.y = pk2(bflo(av.y) + p0.z, bfhi(av.y) + p0.w);
        aw.z = pk2(bflo(av.z) + p1.x, bfhi(av.z) + p1.y); aw.w = pk2(bflo(av.w) + p1.z, bfhi(av.w) + p1.w);
        const bf16x8 af = __builtin_bit_cast(bf16x8, aw);
        const bf16x8 bf0 = *(const bf16x8*)(b0 + ks * 32), bf1 = *(const bf16x8*)(b1 + ks * 32);
        acc0 = __builtin_amdgcn_mfma_f32_16x16x32_bf16(af, bf0, acc0, 0, 0, 0);
        acc1 = __builtin_amdgcn_mfma_f32_16x16x32_bf16(af, bf1, acc1, 0, 0, 0);
    }
#pragma unroll
    for (int e = 0; e < 4; ++e) {
        hid[(4 * fq + e) * 264 + 32 * wid + fr] = (bf16_t)f2bf(gelu_tanh(acc0[e]));
        hid[(4 * fq + e) * 264 + 32 * wid + 16 + fr] = (bf16_t)f2bf(gelu_tanh(acc1[e]));
    }
    __syncthreads();
    if (wid < 4) {
        f32x4 acc = {0.f, 0.f, 0.f, 0.f};
        const bf16_t* bw = W2 + (size_t)(16 * wid + fr) * 256 + 8 * fq;
#pragma unroll
        for (int ks = 0; ks < 8; ++ks) {
            const bf16x8 af = *(const bf16x8*)(hid + fr * 264 + ks * 32 + 8 * fq);
            const bf16x8 bf = *(const bf16x8*)(bw + ks * 32);
            acc = __builtin_amdgcn_mfma_f32_16x16x32_bf16(af, bf, acc, 0, 0, 0);
        }
        const int d = 16 * wid + fr;
        float o[4];
#pragma unroll
        for (int e = 0; e < 4; ++e) o[e] = (nc0 + 4 * fq + e < 255) ? acc[e] : 0.f;
        if (kv == 0) {
            bf16_t* KC = (bf16_t*)(a.ws + WS_KC) + (size_t)((b * 2 + g) * 256) * 64;
#pragma unroll
            for (int e = 0; e < 4; ++e) KC[(size_t)(nc0 + 4 * fq + e) * 64 + d] = (bf16_t)f2bf(o[e]);
        } else {
            bf16_t* VCT = (bf16_t*)(a.ws + WS_VCT) + (size_t)((b * 2 + g) * 64) * 256;
            u32x2 w; w.x = pk2(o[0], o[1]); w.y = pk2(o[2], o[3]);
            *(u32x2*)(VCT + (size_t)d * 256 + nc0 + 4 * fq) = w;
        }
    }
    __syncthreads();
}

template <int PASS>
__device__ __forceinline__ void rnn_item(const Args& a, int l, int item, unsigned char* lds, int tid) {
    const int wid = tid >> 6, lane = tid & 63, fr = lane & 15, fq = lane >> 4;
    const int h = item & 15, c = (item >> 4) & 63, b = item >> 10;
    bf16_t* Z = (bf16_t*)(a.ws + WS_Z);
    float* XRf = (float*)lds;
    float* XC = (float*)(lds + 17408);
    bf16_t* XCB = (bf16_t*)(lds + 17408 + 16640);
    float* AA = (float*)(lds + 43264);
    float* BB = (float*)(lds + 43264 + 16640);
    float* SEGA = (float*)(lds + 76544);
    float* SEGH = SEGA + 512;
    float* CAR = SEGH + 512;
    for (int q = tid; q < 67 * 8; q += NTHREADS) {
        const int rr = q >> 3, ch = q & 7; const int t = c * 64 - 3 + rr;
        u32x4 v = {0u, 0u, 0u, 0u};
        if (t >= 0) v = *(const u32x4*)(Z + (size_t)(b * SEQ + t) * LDZ + ZXR + h * 64 + ch * 8);
        float* d = XRf + rr * 64 + ch * 8;
        d[0] = bflo(v.x); d[1] = bfhi(v.x); d[2] = bflo(v.y); d[3] = bfhi(v.y); d[4] = bflo(v.z); d[5] = bfhi(v.z); d[6] = bflo(v.w); d[7] = bfhi(v.w);
    }
    __syncthreads();
    {
        const int ch = tid & 63, tg = tid >> 6, cg_ = h * 64 + ch;
        const float* cw = a.in[9] + (size_t)l * 4 * DM + cg_;
        const float w0 = cw[0], w1 = cw[DM], w2 = cw[2 * DM], w3 = cw[3 * DM], cb = a.in[10][l * DM + cg_];
#pragma unroll
        for (int k = 0; k < 8; ++k) {
            const int tok = tg * 8 + k;
            float xc = cb;
            xc += XRf[(tok + 0) * 64 + ch] * w0; xc += XRf[(tok + 1) * 64 + ch] * w1; xc += XRf[(tok + 2) * 64 + ch] * w2; xc += XRf[(tok + 3) * 64 + ch] * w3;
            XC[tok * 65 + ch] = xc; XCB[tok * 72 + ch] = (bf16_t)f2bf(xc);
        }
    }
    __syncthreads();
    {
        const bf16_t* WA = (const bf16_t*)(a.ws + WS_W + W_A) + h * 4096;
        const bf16_t* WI = (const bf16_t*)(a.ws + WS_W + W_I) + h * 4096;
#pragma unroll
        for (int q = 0; q < 2; ++q) {
            const int pr = 2 * wid + q, mt = pr >> 2, nt = pr & 3;
            f32x4 ca = {0.f, 0.f, 0.f, 0.f}, ci = {0.f, 0.f, 0.f, 0.f};
#pragma unroll
            for (int ks = 0; ks < 2; ++ks) {
                const bf16x8 af = *(const bf16x8*)(XCB + (16 * mt + fr) * 72 + 32 * ks + 8 * fq);
                const bf16x8 ba = *(const bf16x8*)(WA + (16 * nt + fr) * 64 + 32 * ks + 8 * fq);
                const bf16x8 bi = *(const bf16x8*)(WI + (16 * nt + fr) * 64 + 32 * ks + 8 * fq);
                ca = __builtin_amdgcn_mfma_f32_16x16x32_bf16(af, ba, ca, 0, 0, 0);
                ci = __builtin_amdgcn_mfma_f32_16x16x32_bf16(af, bi, ci, 0, 0, 0);
            }
            const int j = 16 * nt + fr, cg_ = h * 64 + j;
            const float ba_ = a.in[12][l * DM + cg_], bi_ = a.in[14][l * DM + cg_], lam = a.in[15][l * DM + cg_];
            const float sp8 = -8.0f * log1pf(expf(-lam));
#pragma unroll
            for (int e = 0; e < 4; ++e) {
                const int tok = 16 * mt + 4 * fq + e;
                const float r = __builtin_amdgcn_rcpf(1.0f + __expf(-(ca[e] + ba_))), ig = __builtin_amdgcn_rcpf(1.0f + __expf(-(ci[e] + bi_)));
                const float log_a = r * sp8;
                const float av = __expf(log_a);
                const float x2 = 2.0f * log_a;
                const float ser = -x2 * (1.0f + x2 * (0.5f + x2 * (0.16666667f + x2 * 0.041666668f)));
                const float om = (x2 > -0.0625f) ? ser : (1.0f - __expf(x2));
                const float bt = __builtin_amdgcn_sqrtf(om) * (ig * XC[tok * 65 + j]);
                AA[tok * 65 + j] = av; BB[tok * 65 + j] = bt;
            }
        }
    }
    __syncthreads();
    const int ch = tid & 63, sg = tid >> 6;
    float av[8], bv[8];
    {
        float A = 1.f, H = 0.f;
#pragma unroll
        for (int k = 0; k < 8; ++k) { av[k] = AA[(sg * 8 + k) * 65 + ch]; bv[k] = BB[(sg * 8 + k) * 65 + ch]; H = av[k] * H + bv[k]; A *= av[k]; }
        SEGA[sg * 64 + ch] = A; SEGH[sg * 64 + ch] = H;
    }
    float* AGG = (float*)(a.ws + WS_AGG);
    if (PASS == 2 && tid < 64) {
        float Hc = 0.f;
        for (int cc = 0; cc < c; ++cc) { const float2 ah = *(const float2*)(AGG + ((size_t)(b * 64 + cc) * DM + h * 64 + tid) * 2); Hc = ah.x * Hc + ah.y; }
        CAR[tid] = Hc;
    }
    __syncthreads();
    if (PASS == 1) {
        if (tid < 64) {
            float Ac = 1.f, Hc = 0.f;
#pragma unroll
            for (int s = 0; s < 8; ++s) { const float sa = SEGA[s * 64 + tid]; Hc = sa * Hc + SEGH[s * 64 + tid]; Ac *= sa; }
            float2 o; o.x = Ac; o.y = Hc;
            *(float2*)(AGG + ((size_t)(b * 64 + c) * DM + h * 64 + tid) * 2) = o;
        }
    } else {
        float H = CAR[ch];
        for (int s = 0; s < sg; ++s) H = SEGA[s * 64 + ch] * H + SEGH[s * 64 + ch];
        bf16_t* gp = Z + (size_t)(b * SEQ + c * 64 + sg * 8) * LDZ + ZGR + h * 64 + ch;
#pragma unroll
        for (int k = 0; k < 8; ++k) {
            H = av[k] * H + bv[k];
            const float gate = bf2f(gp[(size_t)k * LDZ]);
            gp[(size_t)k * LDZ] = (bf16_t)f2bf(H * gelu_tanh(gate));
        }
    }
    __syncthreads();
}

constexpr int AL_K = 0, AL_V = 18432, AL_PS = 36864, AL_IMP = 103424, AL_SEL = 119808;
constexpr int PSLD = 260;
constexpr float NEGF = -1e30f;

__device__ __forceinline__ float dpp_xor1(float v) { return __builtin_bit_cast(float, __builtin_amdgcn_mov_dpp(__builtin_bit_cast(int, v), 0xB1, 0xF, 0xF, true)); }
__device__ __forceinline__ float dpp_xor2(float v) { return __builtin_bit_cast(float, __builtin_amdgcn_mov_dpp(__builtin_bit_cast(int, v), 0x4E, 0xF, 0xF, true)); }
__device__ __forceinline__ float swap32(float v) { auto r = __builtin_amdgcn_permlane32_swap(__builtin_bit_cast(unsigned, v), __builtin_bit_cast(unsigned, v), false, false); return __builtin_bit_cast(float, (unsigned)r[0]) ; }
template <int MODE>
__device__ __forceinline__ void attn_tile(const unsigned char* Kt, const unsigned char* Vt, const bf16x8 (&qr)[4], bool keymask, int lo, int hi, bool rowon, float& m, float& l, float inv,
                                          f32x16& o0, f32x16& o1, float* psrow, int lane) {
    const int r = lane & 31, hh = lane >> 5;
    f32x16 p[2];
#pragma unroll
    for (int kt = 0; kt < 2; ++kt) {
        f32x16 acc = {};
#pragma unroll
        for (int s = 0; s < 4; ++s) {
            const bf16x8 kf = *(const bf16x8*)(Kt + (32 * kt + r) * 144 + (16 * s + 8 * hh) * 2);
            acc = __builtin_amdgcn_mfma_f32_32x32x16_bf16(kf, qr[s], acc, 0, 0, 0);
        }
        p[kt] = acc;
    }
    if (keymask) {
        const int lo2 = lo - 4 * hh, hi2 = hi - 4 * hh;
#pragma unroll
        for (int kt = 0; kt < 2; ++kt)
#pragma unroll
            for (int rg = 0; rg < 16; ++rg) { const int kc = 32 * kt + (rg & 3) + 8 * (rg >> 2); if (kc < lo2 || kc > hi2) p[kt][rg] = NEGF; }
    }
    float mn = m;
    if (MODE != 1) {
        float t0 = fmaxf(p[0][0], p[1][0]), t1 = fmaxf(p[0][1], p[1][1]);
#pragma unroll
        for (int rg = 2; rg < 16; rg += 2) { t0 = fmaxf(t0, fmaxf(p[0][rg], p[1][rg])); t1 = fmaxf(t1, fmaxf(p[0][rg + 1], p[1][rg + 1])); }
        float tm = fmaxf(t0, t1);
        if (!rowon) tm = NEGF;
        tm = fmaxf(tm, __shfl_xor(tm, 32));
        mn = fmaxf(m, tm);
        const float alpha = __builtin_amdgcn_exp2f(m - mn);
        l *= alpha;
        if (MODE == 2) { if (!__all(alpha == 1.0f)) { o0 = o0 * alpha; o1 = o1 * alpha; } }
        m = mn;
    }
    const float mexp = rowon ? mn : 1e30f;
    float sum0 = 0.f, sum1 = 0.f;
    if (keymask) {
#pragma unroll
        for (int kt = 0; kt < 2; ++kt)
#pragma unroll
            for (int rg = 0; rg < 16; ++rg) {
                const float s = p[kt][rg];
                const float e = (s > -1e29f) ? __builtin_amdgcn_exp2f(s - mexp) : 0.f;
                p[kt][rg] = e; if (rg & 1) sum1 += e; else sum0 += e;
            }
    } else {
#pragma unroll
        for (int kt = 0; kt < 2; ++kt)
#pragma unroll
            for (int rg = 0; rg < 16; ++rg) {
                const float e = __builtin_amdgcn_exp2f(p[kt][rg] - mexp);
                p[kt][rg] = e; if (rg & 1) sum1 += e; else sum0 += e;
            }
    }
    if (MODE != 1) l += sum0 + sum1;
    if (MODE == 0) return;
    if (MODE == 1) {
        float* psrow2 = psrow + 4 * hh;
#pragma unroll
        for (int kt = 0; kt < 2; ++kt)
#pragma unroll
            for (int rg = 0; rg < 16; ++rg) {
                const float e = p[kt][rg] * inv; p[kt][rg] = e;
                float v = e; v += dpp_xor1(v); v += dpp_xor2(v);
                if ((lane & 3) == 0) psrow2[32 * kt + (rg & 3) + 8 * (rg >> 2)] = v;
            }
    }
#pragma unroll
    for (int s = 0; s < 4; ++s) {
        const int kt = s >> 1, rb = 8 * (s & 1);
        u32x4 pw;
        pw.x = pk2(p[kt][rb + 0], p[kt][rb + 1]); pw.y = pk2(p[kt][rb + 2], p[kt][rb + 3]); pw.z = pk2(p[kt][rb + 4], p[kt][rb + 5]); pw.w = pk2(p[kt][rb + 6], p[kt][rb + 7]);
        const bf16x8 pf = __builtin_bit_cast(bf16x8, pw);
#pragma unroll
        for (int dt = 0; dt < 2; ++dt) {
            const unsigned char* vp = Vt + (32 * dt + r) * 144 + (16 * s + 4 * hh) * 2;
            const u32x2 v0 = *(const u32x2*)vp, v1 = *(const u32x2*)(vp + 16);
            u32x4 vw; vw.x = v0.x; vw.y = v0.y; vw.z = v1.x; vw.w = v1.y;
            const bf16x8 vf = __builtin_bit_cast(bf16x8, vw);
            if (dt == 0) o0 = __builtin_amdgcn_mfma_f32_32x32x16_bf16(vf, pf, o0, 0, 0, 0);
            else o1 = __builtin_amdgcn_mfma_f32_32x32x16_bf16(vf, pf, o1, 0, 0, 0);
        }
    }
}

__device__ __forceinline__ void attn_unit(const Args& a, int b, int g, int qt, unsigned char* lds, int tid) {
    const int wid = tid >> 6, lane = tid & 63, hh = lane >> 5;
    const int tokl = (lane & 31) >> 2, head = lane & 3, ti = 8 * wid + tokl, t0 = 64 * qt, t = t0 + ti;
    const unsigned char* zb = a.ws + WS_Z + (size_t)b * SEQ * LDZ * 2 + (size_t)g * 128;
    const unsigned char* kcb = a.ws + WS_KC + (size_t)((b * 2 + g) * 256) * 128;
    const unsigned char* vcb = a.ws + WS_VCT + (size_t)((b * 2 + g) * 64) * 512;
    const unsigned char* vtsb = a.ws + WS_VT + ((size_t)((b * 2 + 0) * 2 + g) * 64) * SEQ * 2;
    const unsigned char* vtwb = a.ws + WS_VT + ((size_t)((b * 2 + 1) * 2 + g) * 64) * SEQ * 2;
    float* PS = (float*)(lds + AL_PS); float* IMP = (float*)(lds + AL_IMP); unsigned long long* SEL = (unsigned long long*)(lds + AL_SEL);
    unsigned char* qrow = a.ws + WS_Z + ((size_t)(b * SEQ + t) * LDZ + ZQ + (g * 4 + head) * 64) * 2;
    bf16x8 qr[4];
#pragma unroll
    for (int s = 0; s < 4; ++s) qr[s] = *(const bf16x8*)(qrow + (16 * s + 8 * hh) * 2);
    float g0, g1, g2;
    { const float* gn = (const float*)(a.ws + WS_GN) + (size_t)(b * SEQ + t) * 32 + (g * 4 + head) * 3; g0 = gn[0]; g1 = gn[1]; g2 = gn[2]; }
    f32x16 out0 = {}, out1 = {};
    const int srow = tid >> 3, sch = tid & 7;
    const unsigned sdst = srow * 144 + sch * 16;
    const unsigned zoff = (unsigned)srow * (LDZ * 2) + sch * 16;
    const unsigned vtoff = (unsigned)srow * (SEQ * 2) + sch * 16;
    u32x4 kreg, vreg;
#define ST_STORE(buf) do { *(u32x4*)(lds + AL_K + (buf) * 9216 + sdst) = kreg; *(u32x4*)(lds + AL_V + (buf) * 9216 + sdst) = vreg; } while (0)

    const int nct = (4 * qt + 66) >> 6;
    const int nmax = (t >= 31) ? ((t - 31) >> 4) : -1;
    float m = NEGF, l = 0.f; f32x16 o0 = {}, o1 = {};
#define CMP_LOAD(c) do { kreg = *(const u32x4*)(kcb + (unsigned)((c) * 8192 + srow * 128 + sch * 16)); vreg = *(const u32x4*)(vcb + (unsigned)(srow * 512 + (c) * 128 + sch * 16)); } while (0)
    CMP_LOAD(0); ST_STORE(0); __syncthreads();
    for (int c = 0; c < nct; ++c) {
        if (c + 1 < nct) CMP_LOAD(c + 1);
        const int hi = nmax - 64 * c;
        attn_tile<0>(lds + AL_K + (c & 1) * 9216, lds + AL_V + (c & 1) * 9216, qr, !__all(hi >= 63), 0, hi, true, m, l, 0.f, o0, o1, nullptr, lane);
        if (c + 1 < nct) ST_STORE((c + 1) & 1);
        __syncthreads();
    }
    {
        const float lt = l + __shfl_xor(l, 32);
        const float inv = lt > 0.f ? 1.0f / lt : 0.f;
        CMP_LOAD(0); ST_STORE(0); __syncthreads();
        for (int c = 0; c < nct; ++c) {
            if (c + 1 < nct) CMP_LOAD(c + 1);
            const int hi = nmax - 64 * c;
            attn_tile<1>(lds + AL_K + (c & 1) * 9216, lds + AL_V + (c & 1) * 9216, qr, !__all(hi >= 63), 0, hi, true, m, l, inv, o0, o1, PS + ti * PSLD + 64 * c, lane);
            if (c + 1 < nct) ST_STORE((c + 1) & 1);
            __syncthreads();
        }
        out0 = o0 * g0; out1 = o1 * g0;
    }
    if (qt < 16) {
        if (tid < 64) SEL[tid] = (qt == 63) ? ~0ull : ((1ull << (qt + 1)) - 1ull);
    } else {
#pragma unroll 1
        for (int k = 0; k < 8; ++k) {
            const int tk = 8 * wid + k; const float* pr = PS + tk * PSLD; const int j = lane;
            float v = 0.f;
            if (j >= 1 && j <= qt) { const float p0 = pr[4 * j], p1 = pr[4 * j - 1], p2 = pr[4 * j - 2], p3 = pr[4 * j - 3], p4 = pr[4 * j - 4];
                v = ((((((p0 + p1) + p1) + p2) + p2) + p3) + p3) + p4; }
            IMP[tk * 64 + j] = v;
        }
        __syncthreads();
#pragma unroll 1
        for (int k = 0; k < 8; ++k) {
            const int tk = 8 * wid + k; const int j = lane; const float mine = IMP[tk * 64 + j];
            int cnt = 0;
            for (int jj = 1; jj <= qt - 2; ++jj) { const float v = IMP[tk * 64 + jj]; cnt += ((v > mine) || (v == mine && jj < j)) ? 1 : 0; }
            const bool sel = (j >= 1 && j <= qt - 2 && cnt < 13) || j == 0 || j == qt - 1 || j == qt;
            const unsigned long long mk = __ballot(sel);
            if (lane == 0) SEL[tk] = mk;
        }
    }
    __syncthreads();
    const unsigned long long mysel = SEL[ti];
    unsigned wlo = (unsigned)mysel, whi = (unsigned)(mysel >> 32);
#pragma unroll
    for (int o = 4; o < 32; o <<= 1) { wlo |= __shfl_xor(wlo, o); whi |= __shfl_xor(whi, o); }
    const unsigned long long wsel = (unsigned long long)__builtin_amdgcn_readfirstlane(wlo) | ((unsigned long long)__builtin_amdgcn_readfirstlane(whi) << 32);

#define KV_LOAD(KOFF, vtb, j) do { kreg = *(const u32x4*)(zb + ((unsigned)(j) * (64u * LDZ * 2u) + zoff + (KOFF) * 2u)); vreg = *(const u32x4*)((vtb) + ((unsigned)(j) * 128u + vtoff)); } while (0)
    {
        m = NEGF; l = 0.f; o0 = (f32x16){}; o1 = (f32x16){};
        const int j0 = qt >= 8 ? qt - 8 : 0, nj = qt - j0 + 1;
        KV_LOAD(ZKW, vtwb, j0); ST_STORE(0); __syncthreads();
        for (int i = 0; i < nj; ++i) {
            const int j = j0 + i;
            if (i + 1 < nj) KV_LOAD(ZKW, vtwb, j + 1);
            const int lo = (j == qt - 8) ? ti + 1 : 0, hi = (j == qt) ? ti : 63;
            attn_tile<2>(lds + AL_K + (i & 1) * 9216, lds + AL_V + (i & 1) * 9216, qr, (j == qt - 8) || (j == qt), lo, hi, true, m, l, 0.f, o0, o1, nullptr, lane);
            if (i + 1 < nj) ST_STORE((i + 1) & 1);
            __syncthreads();
        }
        const float lt = l + __shfl_xor(l, 32);
        const float sc = lt > 0.f ? g2 / lt : 0.f;
        out0 += o0 * sc; out1 += o1 * sc;
    }
    {
        m = NEGF; l = 0.f; o0 = (f32x16){}; o1 = (f32x16){};
        const int nj = qt + 1;
        KV_LOAD(ZKS, vtsb, 0); ST_STORE(0); __syncthreads();
        for (int j = 0; j < nj; ++j) {
            if (j + 1 < nj) KV_LOAD(ZKS, vtsb, j + 1);
            if ((wsel >> j) & 1ull)
                attn_tile<2>(lds + AL_K + (j & 1) * 9216, lds + AL_V + (j & 1) * 9216, qr, j == qt, 0, ti, ((mysel >> j) & 1ull) != 0ull, m, l, 0.f, o0, o1, nullptr, lane);
            if (j + 1 < nj) ST_STORE((j + 1) & 1);
            __syncthreads();
        }
        const float lt = l + __shfl_xor(l, 32);
        const float sc = lt > 0.f ? g1 / lt : 0.f;
        out0 += o0 * sc; out1 += o1 * sc;
    }
#pragma unroll
    for (int rg = 0; rg < 4; ++rg) {
        u32x2 w0; w0.x = pk2(out0[4 * rg], out0[4 * rg + 1]); w0.y = pk2(out0[4 * rg + 2], out0[4 * rg + 3]);
        *(u32x2*)(qrow + (8 * rg + 4 * hh) * 2) = w0;
        u32x2 w1; w1.x = pk2(out1[4 * rg], out1[4 * rg + 1]); w1.y = pk2(out1[4 * rg + 2], out1[4 * rg + 3]);
        *(u32x2*)(qrow + (32 + 8 * rg + 4 * hh) * 2) = w1;
    }
#undef ST_STORE
#undef CMP_LOAD
#undef KV_LOAD
}

__global__ void __launch_bounds__(NTHREADS, 2) nsa_fwd(Args a_unused) {
    extern __shared__ __attribute__((aligned(16))) unsigned char lds[];
    cg::grid_group grid = cg::this_grid();
    const int G0 = gridDim.x, bid0 = blockIdx.x;
    const int wave_s = __builtin_amdgcn_readfirstlane(threadIdx.x >> 6);
#define SIDS() int G = G0, bid = bid0; asm volatile("" : "+s"(G), "+s"(bid))
#define TIDS() SIDS(); const int tid = tid_now(wave_s), lane = tid & 63, wave = __builtin_amdgcn_readfirstlane(tid >> 6), gw = bid * 8 + wave, ngw = G * 8; (void)lane; (void)gw; (void)ngw
    PG8_LAS unsigned char* lds3 = (PG8_LAS unsigned char*)lds;
#define ZP(a) ((bf16_t*)((a).ws + WS_Z))
#define XBP(a) ((bf16_t*)((a).ws + WS_XB))
#define SSQP(a) ((float*)((a).ws + WS_SSQ))
#define WP(a) ((a).ws + WS_W)
#pragma unroll 1
    for (int l = 0; l < DEPTH; ++l) {
#pragma unroll 1
        for (int rep = 0; rep < REP_P0; ++rep)
        { TIDS(); const Args a = load_args(); phase_weights(a, l, lds, gw, ngw, wave, lane); }
        if (l == 0) { TIDS(); const Args a = load_args(); phase_x0(a, gw, ngw, lane); }
        grid.sync();
        {
            SIDS(); const Args a = load_args();
            pg8::Gemm gm{XBP(a), (const bf16_t*)(WP(a) + W_IN), TOK, NIN, DM, DM}; pg8::StaticOrder S; S.init(TOK, NIN, G, bid);
            fill_rtab(S, SSQP(a) + (size_t)(2 * l) * TOK * 16, (float*)(lds + RTAB_OFF), tid_now(wave_s));
            EpiIn E{ZP(a), (float*)(a.ws + WS_GN), (const float*)(lds + RTAB_OFF), 0};
            pg8::gemm_phase<EpiIn, pg8::StaticOrder, true, true>(lds3, gm, S, E, tid_now(wave_s));
        }
        grid.sync();
#pragma unroll 1
        for (int rep = 0; rep < REP_P2; ++rep) {
        { TIDS(); const Args a = load_args(); for (int it = bid; it < 1024; it += G) vt_item(a, it, lds, tid); }
        { TIDS(); const Args a = load_args(); for (int it = bid; it < 256; it += G) cmp_item(a, l, it, lds, tid); }
        { TIDS(); const Args a = load_args(); for (int it = bid; it < 4096; it += G) rnn_item<1>(a, l, it, lds, tid); }
        }
        grid.sync();
        { TIDS(); const Args a = load_args(); for (int it = bid; it < 4096; it += G) rnn_item<2>(a, l, it, lds, tid); }
        {
            SIDS();
#pragma unroll 1
            for (int u = bid * 2; u < 512; u += G * 2) {
#pragma unroll 1
                for (int h2 = 0; h2 < 2; ++h2) {
                    const int bg = u >> 6, s = (u & 63) >> 1;
                    int b_ = bg >> 1, g_ = bg & 1, qt_ = h2 ? s : 63 - s;
                    asm volatile("" : "+s"(b_), "+s"(g_), "+s"(qt_));
                    const Args a = load_args();
                    attn_unit(a, b_, g_, qt_, lds, tid_now(wave_s));
                }
            }
        }
        grid.sync();
        {
            SIDS(); const Args a = load_args();
            pg8::Gemm gm{ZP(a) + ZQ, (const bf16_t*)(WP(a) + W_UPA), TOK, DM, 512, LDZ}; pg8::StaticOrder S; S.init(TOK, DM, G, bid);
            EpiUp<0> E{ZP(a)};
            pg8::gemm_phase<EpiUp<0>, pg8::StaticOrder, true, true>(lds3, gm, S, E, tid_now(wave_s));
        }
        {
            SIDS(); const Args a = load_args();
            pg8::Gemm gm{ZP(a) + ZGR, (const bf16_t*)(WP(a) + W_UPR), TOK, DM, DM, LDZ}; pg8::StaticOrder S; S.init(TOK, DM, G, bid);
            EpiUp<1> E{ZP(a)};
            pg8::gemm_phase<EpiUp<1>, pg8::StaticOrder, true, true>(lds3, gm, S, E, tid_now(wave_s));
        }
        grid.sync();
        {
            SIDS(); const Args a = load_args();
            pg8::Gemm gm{ZP(a) + ZXR, (const bf16_t*)(WP(a) + W_OUT), TOK, DM, DM, LDZ}; pg8::StaticOrder S; S.init(TOK, DM, G, bid);
            EpiRes E{a.out, XBP(a), SSQP(a) + (size_t)(2 * l + 1) * TOK * 16};
            pg8::gemm_phase<EpiRes, pg8::StaticOrder, true, true>(lds3, gm, S, E, tid_now(wave_s));
        }
        grid.sync();
        {
            SIDS(); const Args a = load_args();
            pg8::Gemm gm{XBP(a), (const bf16_t*)(WP(a) + W_1), TOK, DFF, DM, DM}; pg8::StaticOrder S; S.init(TOK, DFF, G, bid);
            fill_rtab(S, SSQP(a) + (size_t)(2 * l + 1) * TOK * 16, (float*)(lds + RTAB_OFF), tid_now(wave_s));
            EpiMlpUp E{ZP(a), (const float*)(lds + RTAB_OFF), 0};
            pg8::gemm_phase<EpiMlpUp, pg8::StaticOrder, true, true>(lds3, gm, S, E, tid_now(wave_s));
        }
        grid.sync();
        {
            SIDS(); const Args a = load_args();
            pg8::Gemm gm{ZP(a), (const bf16_t*)(WP(a) + W_2), TOK, DM, DFF, DFF}; pg8::StaticOrder S; S.init(TOK, DM, G, bid);
            EpiRes E{a.out, XBP(a), SSQP(a) + (size_t)(2 * l + 2) * TOK * 16};
            pg8::gemm_phase<EpiRes, pg8::StaticOrder, true, true>(lds3, gm, S, E, tid_now(wave_s));
        }
        grid.sync();
    }
    { TIDS(); const Args a = load_args(); phase_final(a, gw, ngw, lane); }
}

extern "C" void kernel_launch(void* const* d_in, const int* in_sizes, int n_in, void* d_out, int out_size, void* d_ws, size_t ws_size, hipStream_t stream) {
    static int grid = 0;
    if (grid == 0) {
        int dev = 0, cus = 0, per_cu = 0;
        hipGetDevice(&dev);
        hipDeviceGetAttribute(&cus, hipDeviceAttributeMultiprocessorCount, dev);
        hipFuncSetAttribute((const void*)nsa_fwd, hipFuncAttributeMaxDynamicSharedMemorySize, LDS_BYTES);
        hipOccupancyMaxActiveBlocksPerMultiprocessor(&per_cu, (const void*)nsa_fwd, NTHREADS, LDS_BYTES);
        if (per_cu < 1) per_cu = 1;
        grid = cus * per_cu;
        if (n_in != 23 || ws_size < WS_END) fprintf(stderr, "kernel_launch: unexpected n_in %d / ws %zu\n", n_in, ws_size);
        fprintf(stderr, "kernel_launch: grid %d (cus %d x %d)\n", grid, cus, per_cu);
    }
    Args a{};
    for (int i = 0; i < 23; ++i) a.in[i] = (const float*)d_in[i];
    a.out = (float*)d_out; a.ws = (unsigned char*)d_ws;
    void* args[] = {&a};
    hipError_t e = hipLaunchCooperativeKernel((const void*)nsa_fwd, dim3(grid), dim3(NTHREADS), args, LDS_BYTES, stream);
    if (e != hipSuccess) fprintf(stderr, "cooperative launch failed: %s (grid %d)\n", hipGetErrorString(e), grid);
}
```

```cpp
#include <hip/hip_runtime.h>
#include <hip/hip_cooperative_groups.h>
#include <cstdio>
#include <cstdint>
namespace cg = cooperative_groups;
namespace pg8 {
#define PG8_LAS __attribute__((address_space(3)))
typedef unsigned short bf16_t;
typedef short bf16x8 __attribute__((ext_vector_type(8)));
typedef float f32x4 __attribute__((ext_vector_type(4)));
typedef unsigned u32x4 __attribute__((ext_vector_type(4)));
constexpr int BM = 256, BK = 64, HALF = 128, HTB = HALF * BK * 2  , STAGE_BYTES = 8 * HTB, NXCD = 8, WGM = 8;

__host__ __device__ __forceinline__ int lds_byte(int r, int c) { const int st = (r >> 4) * 2 + (c >> 5), rr = r & 15, cc = c & 31, ob = rr * 64 + cc * 2; return st * 1024 + (ob ^ (((ob >> 9) & 1) << 5)); }
__host__ __device__ __forceinline__ void stage_rc(int b, int& R, int& C) { const int st = b / 1024, sb = b % 1024, swz = sb ^ (((sb >> 9) & 1) << 5); R = (st >> 1) * 16 + swz / 64; C = (st & 1) * 32 + (swz % 64) / 2; }
__host__ __device__ __forceinline__ int perm32(int rho) { const int n = rho >> 4, i = rho & 15; return 8 * (i >> 2) + 4 * n + (i & 3); }

struct Unit { int pm, pn; };
struct Gemm { const bf16_t* A; const bf16_t* Bt; int M, N, K, lda; };

struct StaticOrder {
    int nM, nN, nwg, G, c;
    __host__ __device__ void init(int M, int N, int G_, int c_) { nM = M / BM; nN = N / BM; nwg = nM * nN; G = G_; c = c_; }
    __host__ __device__ bool next(int i, Unit& u) const {
        const long L = (long)i * G + c; if (L >= nwg) return false;
        int wgid = (int)L; { const int q = nwg / NXCD, r = nwg % NXCD, xcd = wgid % NXCD, off = wgid / NXCD; wgid = (xcd < r ? xcd * (q + 1) : r * (q + 1) + (xcd - r) * q) + off; }
        const int nig = WGM * nN, gid = wgid / nig, fm = gid * WGM, gsz = (nM - fm) < WGM ? (nM - fm) : WGM;
        u.pm = fm + ((wgid % nig) % gsz); u.pn = (wgid % nig) / gsz; return true;
    }
    __device__ __forceinline__ void a_ready(const Unit&) const {}
    __device__ __forceinline__ void done(const Unit&) const {}
};

__device__ __forceinline__ unsigned cvt_pk_bf16(float lo, float hi) { unsigned r; asm volatile("v_cvt_pk_bf16_f32 %0, %1, %2" : "=v"(r) : "v"(lo), "v"(hi)); return r; }
typedef float f32x2 __attribute__((ext_vector_type(2)));
template <class Epi, class Sched, bool ALIGN_EPI = false, bool SP2 = false>
__device__ __forceinline__ void gemm_phase(PG8_LAS unsigned char* lds, const Gemm g, const Sched& S, const Epi& E, int tid_in) {
    int tid_ = tid_in; asm volatile("" : "+v"(tid_)); const int tid = tid_, wid = __builtin_amdgcn_readfirstlane(tid >> 6), lane = tid & 63, wr = wid >> 2, wc = wid & 3, fr = lane & 15, fq = lane >> 4;
    const int K = g.K, nt = K / BK;
    unsigned voffA[2], voffB[2];
#pragma unroll
    for (int i = 0; i < 2; ++i) { int R, C; stage_rc(tid * 16 + i * 8192, R, C); const int Rb = Epi::PERM ? ((R & ~31) + perm32(R & 31)) : R;
        voffA[i] = (unsigned)(R * g.lda + C) * 2u; voffB[i] = (unsigned)(Rb * K + C) * 2u; }
    const size_t kstep = (size_t)(BK * 2);
    const size_t hstep = (size_t)HALF * K * 2;
    const size_t tstep = 2 * hstep; const size_t hstepA = (size_t)HALF * g.lda * 2, tstepA = 2 * hstepA;
    const unsigned ldsw = (unsigned)wid * 1024u;
    const int aoff = lds_byte(wr * 64 + fr, fq * 8), boff = lds_byte(wc * 32 + fr, fq * 8);
#define PG8_SA(b, h) (((b) * 2 + (h)) * HTB)
#define PG8_SB(b, h) ((4 + (b) * 2 + (h)) * HTB)
#define PG8_STAGE(bufoff, gbase, voff) do { _Pragma("unroll") for (int _i = 0; _i < 2; ++_i) \
        __builtin_amdgcn_global_load_lds((const unsigned*)((const char*)(gbase) + (voff)[_i]), (PG8_LAS unsigned*)(lds + (bufoff) + ldsw + _i * 8192), 16, 0, 0); } while (0)
#define PG8_LDA(dst, b, h) do { _Pragma("unroll") for (int m = 0; m < 4; ++m) _Pragma("unroll") for (int k = 0; k < 2; ++k) dst[m][k] = *(const PG8_LAS bf16x8*)(lds + PG8_SA(b, h) + aoff + m * 2048 + k * 1024); } while (0)
#define PG8_LDB(dst, b, h) do { _Pragma("unroll") for (int n = 0; n < 2; ++n) _Pragma("unroll") for (int k = 0; k < 2; ++k) dst[n][k] = *(const PG8_LAS bf16x8*)(lds + PG8_SB(b, h) + boff + n * 2048 + k * 1024); } while (0)
#define PG8_MMA(ai, bj, At, Bt) do { __builtin_amdgcn_s_setprio(1); _Pragma("unroll") for (int m = 0; m < 4; ++m) _Pragma("unroll") for (int n = 0; n < 2; ++n) _Pragma("unroll") for (int k = 0; k < 2; ++k) \
        acc[ai][bj][m][n] = __builtin_amdgcn_mfma_f32_16x16x32_bf16(Bt[n][k], At[m][k], acc[ai][bj][m][n], 0, 0, 0); __builtin_amdgcn_s_setprio(0); } while (0)
#define PG8_WAIT_V(n) asm volatile("s_waitcnt vmcnt(" #n ")" ::: "memory")
#define PG8_WAIT_L(n) asm volatile("s_waitcnt lgkmcnt(" #n ")" ::: "memory")
#define PG8_BAR __builtin_amdgcn_s_barrier()
#define PG8_SCHED __builtin_amdgcn_sched_barrier(0)
    Unit cur, nxt; int ui = 0;
    if (!S.next(0, cur)) return;
    f32x4 acc[2][2][4][2];
#pragma unroll
    for (int a = 0; a < 2; ++a)
#pragma unroll
        for (int b = 0; b < 2; ++b)
#pragma unroll
            for (int m = 0; m < 4; ++m)
#pragma unroll
                for (int n = 0; n < 2; ++n) acc[a][b][m][n] = (f32x4){0.f, 0.f, 0.f, 0.f};
    bf16x8 At[4][2], B0[2][2], B1[2][2];
    const char* cA = (const char*)g.A + (size_t)cur.pm * tstepA; const char* cB = (const char*)g.Bt + (size_t)cur.pn * tstep;
    S.a_ready(cur);
    if constexpr (SP2) {
        PG8_STAGE(PG8_SB(0, 0), cB, voffB); PG8_STAGE(PG8_SB(0, 1), cB + hstep, voffB); PG8_STAGE(PG8_SA(0, 0), cA, voffA); PG8_STAGE(PG8_SA(0, 1), cA + hstepA, voffA);
        if (wr == 1) PG8_BAR;
        PG8_WAIT_V(2); PG8_BAR;
        PG8_STAGE(PG8_SB(1, 0), cB + kstep, voffB); PG8_STAGE(PG8_SA(1, 0), cA + kstep, voffA); PG8_STAGE(PG8_SB(1, 1), cB + hstep + kstep, voffB);
        PG8_WAIT_V(6); PG8_BAR;
    } else {
        PG8_STAGE(PG8_SB(0, 0), cB, voffB); PG8_STAGE(PG8_SA(0, 0), cA, voffA); PG8_STAGE(PG8_SB(0, 1), cB + hstep, voffB); PG8_STAGE(PG8_SA(0, 1), cA + hstepA, voffA);
        if (wr == 1) PG8_BAR;
        PG8_WAIT_V(4); PG8_BAR;
        PG8_STAGE(PG8_SB(1, 0), cB + kstep, voffB); PG8_STAGE(PG8_SA(1, 0), cA + kstep, voffA); PG8_STAGE(PG8_SB(1, 1), cB + hstep + kstep, voffB);
        PG8_WAIT_V(6); PG8_BAR;
    }
    for (;;) {
        const bool has_next = S.next(ui + 1, nxt);
        const char* nA = has_next ? (const char*)g.A + (size_t)nxt.pm * tstepA : cA; const char* nB = has_next ? (const char*)g.Bt + (size_t)nxt.pn * tstep : cB;
        for (int t = 0; t < nt; t += 2) {
            const bool last = (t == nt - 2);
            const char* a1 = cA + (size_t)(t + 1) * kstep;
            const char* a2 = last ? nA : cA + (size_t)(t + 2) * kstep; const char* b2 = last ? nB : cB + (size_t)(t + 2) * kstep;
            const char* a3 = a2 + kstep; const char* b3 = b2 + kstep;
            if (last && has_next) S.a_ready(nxt);
            if constexpr (SP2) {
            PG8_LDB(B0, 0, 0); PG8_LDB(B1, 0, 1); PG8_SCHED; PG8_LDA(At, 0, 0); PG8_STAGE(PG8_SA(1, 1), a1 + hstepA, voffA);
            PG8_WAIT_V(8); PG8_WAIT_L(0); PG8_BAR; PG8_MMA(0, 0, At, B0); PG8_MMA(0, 1, At, B1); PG8_BAR; PG8_SCHED;
            PG8_LDA(At, 0, 1); PG8_STAGE(PG8_SB(0, 0), b2, voffB); PG8_STAGE(PG8_SB(0, 1), b2 + hstep, voffB); PG8_STAGE(PG8_SA(0, 0), a2, voffA);
            PG8_WAIT_V(8); PG8_WAIT_L(0); PG8_BAR; PG8_MMA(1, 0, At, B0); PG8_MMA(1, 1, At, B1); PG8_BAR; PG8_SCHED;
            PG8_LDB(B0, 1, 0); PG8_LDB(B1, 1, 1); PG8_SCHED; PG8_LDA(At, 1, 0); PG8_STAGE(PG8_SA(0, 1), a2 + hstepA, voffA);
            PG8_WAIT_V(8); PG8_WAIT_L(0); PG8_BAR; PG8_MMA(0, 0, At, B0); PG8_MMA(0, 1, At, B1); PG8_BAR; PG8_SCHED;
            PG8_LDA(At, 1, 1); PG8_STAGE(PG8_SB(1, 0), b3, voffB); PG8_STAGE(PG8_SB(1, 1), b3 + hstep, voffB); PG8_STAGE(PG8_SA(1, 0), a3, voffA);
            PG8_WAIT_V(8); PG8_WAIT_L(0); PG8_BAR; PG8_MMA(1, 0, At, B0); PG8_MMA(1, 1, At, B1); PG8_BAR; PG8_SCHED;
            } else {
            PG8_LDB(B0, 0, 0); PG8_SCHED; PG8_LDA(At, 0, 0); PG8_STAGE(PG8_SA(1, 1), a1 + hstepA, voffA);
            PG8_WAIT_L(8); PG8_BAR; PG8_WAIT_L(0); PG8_MMA(0, 0, At, B0); PG8_BAR; PG8_SCHED;
            PG8_LDB(B1, 0, 1); PG8_STAGE(PG8_SB(0, 0), b2, voffB);
            PG8_BAR; PG8_WAIT_L(0); PG8_MMA(0, 1, At, B1); PG8_BAR;
            PG8_LDA(At, 0, 1); PG8_STAGE(PG8_SA(0, 0), a2, voffA);
            PG8_BAR; PG8_WAIT_L(0); PG8_MMA(1, 0, At, B0); PG8_BAR; PG8_SCHED;
            PG8_STAGE(PG8_SB(0, 1), b2 + hstep, voffB);
            PG8_WAIT_V(6); PG8_BAR; PG8_MMA(1, 1, At, B1); PG8_BAR;
            PG8_LDB(B0, 1, 0); PG8_SCHED; PG8_LDA(At, 1, 0); PG8_STAGE(PG8_SA(0, 1), a2 + hstepA, voffA);
            PG8_WAIT_L(8); PG8_BAR; PG8_WAIT_L(0); PG8_MMA(0, 0, At, B0); PG8_BAR; PG8_SCHED;
            PG8_LDB(B1, 1, 1); PG8_STAGE(PG8_SB(1, 0), b3, voffB);
            PG8_BAR; PG8_WAIT_L(0); PG8_MMA(0, 1, At, B1); PG8_BAR;
            PG8_LDA(At, 1, 1); PG8_STAGE(PG8_SA(1, 0), a3, voffA);
            PG8_BAR; PG8_WAIT_L(0); PG8_MMA(1, 0, At, B0); PG8_BAR; PG8_SCHED;
            PG8_STAGE(PG8_SB(1, 1), b3 + hstep, voffB);
            PG8_WAIT_V(6); PG8_BAR; PG8_MMA(1, 1, At, B1); PG8_BAR;
            }
        }
        if constexpr (ALIGN_EPI) { if (wr == 0) PG8_BAR; }
        if constexpr (!Epi::AFTER_DRAIN) { E(acc, cur, wr, wc, fr, fq); S.done(cur); }
        if (!has_next) break;
#pragma unroll
        for (int a = 0; a < 2; ++a)
#pragma unroll
            for (int b = 0; b < 2; ++b)
#pragma unroll
                for (int m = 0; m < 4; ++m)
#pragma unroll
                    for (int n = 0; n < 2; ++n) acc[a][b][m][n] = (f32x4){0.f, 0.f, 0.f, 0.f};
        cur = nxt; cA = nA; cB = nB; ++ui;
        if constexpr (ALIGN_EPI) { if (wr == 1) PG8_BAR; }
    }
    PG8_WAIT_V(0);
    if constexpr (!ALIGN_EPI) { if (wr == 0) PG8_BAR; }
    PG8_BAR;
    if constexpr (Epi::AFTER_DRAIN) { E.fused(acc, cur, wr, wc, fr, fq, lds, wid, lane); S.done(cur); }
#undef PG8_SA
#undef PG8_SB
#undef PG8_STAGE
#undef PG8_LDA
#undef PG8_LDB
#undef PG8_MMA
#undef PG8_WAIT_V
#undef PG8_WAIT_L
#undef PG8_BAR
#undef PG8_SCHED
}
}
using pg8::bf16_t; using pg8::bf16x8; using pg8::f32x4; using pg8::u32x4;
typedef float f32x16 __attribute__((ext_vector_type(16)));
typedef unsigned u32x2 __attribute__((ext_vector_type(2)));
typedef short s16x4 __attribute__((ext_vector_type(4)));

constexpr int BATCH = 4, SEQ = 4096, DM = 1024, TOK = BATCH * SEQ, DEPTH = 2, DFF = 4096;
constexpr int LDZ = 5376, NIN = 5632, DIN = 5400;
constexpr int ZQ = 0, ZKC = 512, ZVC = 640, ZKS = 768, ZVS = 896, ZKW = 1024, ZVW = 1152, ZXR = 1280, ZGR = 2304, ZGA = 3328, ZGB = 4352;
constexpr float EPSN = 1e-6f;
constexpr float QSCALE = 0.125f * 1.4426950408889634f;
constexpr int NTHREADS = 512;
#ifndef REP_P0
#define REP_P0 1
#endif
#ifndef REP_P2
#define REP_P2 1
#endif
constexpr int LDS_BYTES = 147456;

constexpr size_t MiB = 1u << 20;
constexpr size_t W_IN = 0, W_UPA = 11 * MiB, W_UPR = 12 * MiB, W_OUT = 14 * MiB, W_1 = 16 * MiB, W_2 = 24 * MiB, W_CK1 = 32 * MiB, W_CV1 = 33 * MiB,
                 W_CK2 = 34 * MiB, W_CV2 = 34 * MiB + 32768, W_A = 34 * MiB + 65536, W_I = 34 * MiB + 65536 + 131072;
constexpr size_t WS_W = 0, WS_Z = 36 * MiB, WS_XB = 204 * MiB, WS_GN = 236 * MiB, WS_SSQ = 238 * MiB, WS_KC = 243 * MiB, WS_VCT = 243 * MiB + 262144,
                 WS_VT = 244 * MiB, WS_AGG = 252 * MiB, WS_CTL = 254 * MiB, WS_END = 254 * MiB + 16384;

struct Args { const float* in[23]; float* out; unsigned char* ws; };
typedef const __attribute__((address_space(4))) Args* ArgsP;
__device__ __forceinline__ int tid_now(int wave_s) { int t; asm volatile("v_mbcnt_lo_u32_b32 %0, -1, 0\n\tv_mbcnt_hi_u32_b32 %0, -1, %0\n\tv_lshl_add_u32 %0, %1, 6, %0" : "=&v"(t) : "s"(wave_s)); return t; }
__device__ __forceinline__ Args load_args() {
    Args r{};
#if defined(__HIP_DEVICE_COMPILE__)
    ArgsP p = (ArgsP)__builtin_amdgcn_kernarg_segment_ptr(); asm volatile("" : "+s"(p));
#pragma unroll
    for (int i = 0; i < 23; ++i) r.in[i] = p->in[i];
    r.out = p->out; r.ws = p->ws;
#endif
    return r;
}

__device__ __forceinline__ unsigned f2bf(float f) { unsigned u = __builtin_bit_cast(unsigned, f); return (u + 0x7fffu + ((u >> 16) & 1u)) >> 16; }
__device__ __forceinline__ unsigned pk2(float lo, float hi) { return pg8::cvt_pk_bf16(lo, hi); }
__device__ __forceinline__ float bf2f(unsigned short v) { return __builtin_bit_cast(float, (unsigned)v << 16); }
__device__ __forceinline__ float bflo(unsigned v) { return __builtin_bit_cast(float, v << 16); }
__device__ __forceinline__ float bfhi(unsigned v) { return __builtin_bit_cast(float, v & 0xffff0000u); }
__device__ __forceinline__ float sigmoidf_(float x) { return __builtin_amdgcn_rcpf(1.0f + __expf(-x)); }
__device__ __forceinline__ float gelu_tanh(float x) {
    const float y = 0.7978845608028654f * (x + 0.044715f * x * x * x);
    const float e = __expf(2.0f * y);
    const float th = 1.0f - 2.0f * __builtin_amdgcn_rcpf(e + 1.0f);
    return 0.5f * x * (1.0f + th);
}
__device__ __forceinline__ float wave_sum(float v) {
#pragma unroll
    for (int o = 1; o < 64; o <<= 1) v += __shfl_xor(v, o);
    return v;
}
__device__ __forceinline__ float rstd_from_ssq(const float* p) {
    const f32x4 a = *(const f32x4*)p, b = *(const f32x4*)(p + 4), c = *(const f32x4*)(p + 8), d = *(const f32x4*)(p + 12);
    const float s = ((a.x + a.y) + (a.z + a.w)) + ((b.x + b.y) + (b.z + b.w)) + ((c.x + c.y) + (c.z + c.w)) + ((d.x + d.y) + (d.z + d.w));
    return rsqrtf(s * (1.0f / 1024.0f) + EPSN);
}

struct EpiIn {
    static constexpr bool PERM = true, AFTER_DRAIN = false;
    bf16_t* Z; float* GN; bf16_t* VT; const float* rtab; mutable int ui;
    __device__ __forceinline__ void operator()(const f32x4 (&acc)[2][2][4][2], const pg8::Unit& u, int wr, int wc, int fr, int fq) const {
        const int row0 = u.pm * 256 + wr * 64 + fr;
        const float* rt = rtab + ui * 256 + wr * 64 + fr; ++ui;
#pragma unroll
        for (int ai = 0; ai < 2; ++ai)
#pragma unroll
            for (int m = 0; m < 4; ++m) {
                const int row = row0 + ai * 128 + m * 16;
                const float rstd = rt[ai * 128 + m * 16];
                asm volatile("" ::: "memory");
                if (u.pn < 21) {
                    const float sc = rstd * (u.pn < 2 ? QSCALE : 1.0f);
                    bf16_t* rowp = Z + (size_t)row * LDZ + u.pn * 256 + wc * 32 + 8 * fq;
#pragma unroll
                    for (int bj = 0; bj < 2; ++bj) {
                        const f32x4 v0 = acc[ai][bj][m][0] * sc, v1 = acc[ai][bj][m][1] * sc;
                        u32x4 w; w.x = pk2(v0[0], v0[1]); w.y = pk2(v0[2], v0[3]); w.z = pk2(v1[0], v1[1]); w.w = pk2(v1[2], v1[3]);
                        if (bj == 1 && (u.pn == 3 || u.pn == 4)) {
                            const int cc = wc * 32 + 8 * fq, g_ = cc >> 6, d0 = cc & 63, b_ = row >> 12, t_ = row & (SEQ - 1);
                            bf16_t* vp = VT + ((size_t)((b_ * 2 + (u.pn - 3)) * 2 + g_) * 64 + d0) * SEQ + t_;
                            const unsigned ww[4] = {w.x, w.y, w.z, w.w};
#pragma unroll
                            for (int e = 0; e < 4; ++e) { vp[(size_t)(2 * e) * SEQ] = (bf16_t)(ww[e] & 0xffffu); vp[(size_t)(2 * e + 1) * SEQ] = (bf16_t)(ww[e] >> 16); }
                        } else *(u32x4*)(rowp + bj * 128) = w;
                    }
                } else if (wc == 0) {
                    float* gp = GN + (size_t)row * 32 + 8 * fq;
#pragma unroll
                    for (int n = 0; n < 2; ++n) {
                        const f32x4 v = acc[ai][0][m][n] * rstd;
                        f32x4 o; o.x = sigmoidf_(v.x); o.y = sigmoidf_(v.y); o.z = sigmoidf_(v.z); o.w = sigmoidf_(v.w);
                        *(f32x4*)(gp + 4 * n) = o;
                    }
                }
            }
    }
};
template <int MODE>
struct EpiUp {
    static constexpr bool PERM = true, AFTER_DRAIN = false;
    bf16_t* Z;
    __device__ __forceinline__ void operator()(const f32x4 (&acc)[2][2][4][2], const pg8::Unit& u, int wr, int wc, int fr, int fq) const {
        const int row0 = u.pm * 256 + wr * 64 + fr;
        const int col0 = u.pn * 256 + wc * 32 + 8 * fq;
#pragma unroll
        for (int ai = 0; ai < 2; ++ai)
#pragma unroll
            for (int m = 0; m < 4; ++m) {
                bf16_t* rowp = Z + (size_t)(row0 + ai * 128 + m * 16) * LDZ + col0;
                asm volatile("" ::: "memory");
#pragma unroll
                for (int bj = 0; bj < 2; ++bj) {
                    const u32x4 gg = *(const u32x4*)(rowp + (MODE == 0 ? ZGA : ZGB) + bj * 128);
                    float g[8] = {bflo(gg.x), bfhi(gg.x), bflo(gg.y), bfhi(gg.y), bflo(gg.z), bfhi(gg.z), bflo(gg.w), bfhi(gg.w)};
                    float v[8];
#pragma unroll
                    for (int e = 0; e < 4; ++e) { v[e] = sigmoidf_(g[e]) * acc[ai][bj][m][0][e]; v[4 + e] = sigmoidf_(g[4 + e]) * acc[ai][bj][m][1][e]; }
                    if (MODE == 1) {
                        const u32x4 tt = *(const u32x4*)(rowp + ZXR + bj * 128);
                        v[0] += bflo(tt.x); v[1] += bfhi(tt.x); v[2] += bflo(tt.y); v[3] += bfhi(tt.y); v[4] += bflo(tt.z); v[5] += bfhi(tt.z); v[6] += bflo(tt.w); v[7] += bfhi(tt.w);
                    }
                    u32x4 w; w.x = pk2(v[0], v[1]); w.y = pk2(v[2], v[3]); w.z = pk2(v[4], v[5]); w.w = pk2(v[6], v[7]);
                    *(u32x4*)(rowp + ZXR + bj * 128) = w;
                }
            }
    }
};
template <bool SRC_F32>
struct EpiRes {
    static constexpr bool PERM = false, AFTER_DRAIN = false;
    const float* Xin; bf16_t* XB; float* ssq;
    __device__ __forceinline__ void operator()(const f32x4 (&acc)[2][2][4][2], const pg8::Unit& u, int wr, int wc, int fr, int fq) const {
        const int row0 = u.pm * 256 + wr * 64 + fr;
        const int col0 = u.pn * 256 + wc * 32 + 4 * fq;
#pragma unroll
        for (int ai = 0; ai < 2; ++ai)
#pragma unroll
            for (int m = 0; m < 4; ++m) {
                const int row = row0 + ai * 128 + m * 16;
                float ss = 0.f;
                asm volatile("" ::: "memory");
#pragma unroll
                for (int bj = 0; bj < 2; ++bj)
#pragma unroll
                    for (int n = 0; n < 2; ++n) {
                        const size_t off = (size_t)row * DM + col0 + bj * 128 + n * 16;
                        f32x4 v;
                        if (SRC_F32) v = *(const f32x4*)(Xin + off);
                        else { const u32x2 xo = *(const u32x2*)(XB + off); v = (f32x4){bflo(xo.x), bfhi(xo.x), bflo(xo.y), bfhi(xo.y)}; }
                        v = v + acc[ai][bj][m][n];
                        u32x2 w; w.x = pk2(v.x, v.y); w.y = pk2(v.z, v.w);
                        *(u32x2*)(XB + off) = w;
                        ss += (v.x * v.x + v.y * v.y) + (v.z * v.z + v.w * v.w);
                    }
                ss += __shfl_xor(ss, 16); ss += __shfl_xor(ss, 32);
                if (fq == 0) ssq[(size_t)row * 16 + u.pn * 4 + wc] = ss;
            }
    }
};
struct EpiMlpUp {
    static constexpr bool PERM = true, AFTER_DRAIN = false;
    bf16_t* H; const float* rtab; mutable int ui;
    __device__ __forceinline__ void operator()(const f32x4 (&acc)[2][2][4][2], const pg8::Unit& u, int wr, int wc, int fr, int fq) const {
        const int row0 = u.pm * 256 + wr * 64 + fr;
        const int col0 = u.pn * 256 + wc * 32 + 8 * fq;
        const float* rt = rtab + ui * 256 + wr * 64 + fr; ++ui;
#pragma unroll
        for (int ai = 0; ai < 2; ++ai)
#pragma unroll
            for (int m = 0; m < 4; ++m) {
                const int row = row0 + ai * 128 + m * 16;
                const float rstd = rt[ai * 128 + m * 16];
                asm volatile("" ::: "memory");
                bf16_t* rowp = H + (size_t)row * DFF + col0;
#pragma unroll
                for (int bj = 0; bj < 2; ++bj) {
                    f32x4 v0 = acc[ai][bj][m][0] * rstd, v1 = acc[ai][bj][m][1] * rstd;
#pragma unroll
                    for (int e = 0; e < 4; ++e) { const float a = fmaxf(v0[e], 0.f), b = fmaxf(v1[e], 0.f); v0[e] = a * a; v1[e] = b * b; }
                    u32x4 w; w.x = pk2(v0[0], v0[1]); w.y = pk2(v0[2], v0[3]); w.z = pk2(v1[0], v1[1]); w.w = pk2(v1[2], v1[3]);
                    *(u32x4*)(rowp + bj * 128) = w;
                }
            }
    }
};

constexpr int RTAB_OFF = 131072;
__device__ __forceinline__ void fill_rtab(const pg8::StaticOrder& S, const float* ssq, float* tab, int tid) {
    pg8::Unit u;
    for (int i = 0; S.next(i, u); ++i)
        if (tid < 256) tab[i * 256 + tid] = rstd_from_ssq(ssq + (size_t)(u.pm * 256 + tid) * 16);
    __syncthreads();
}
__device__ __forceinline__ void tr_item(const float* W, int ldn, int k0, int src_n0, int nvalid, const float* ks, bf16_t* dst, int dstK, int dst_row0, float* scr, int lane) {
    const int n = lane & 31;
    float wv[32];
    const float* wp = W + (size_t)(k0 + (lane >> 5)) * ldn + src_n0 + n;
#pragma unroll
    for (int i = 0; i < 32; ++i) wv[i] = (n < nvalid) ? __builtin_nontemporal_load(wp + (size_t)(2 * i) * ldn) : 0.f;
#pragma unroll
    for (int i = 0; i < 32; ++i) {
        const int kk = 2 * i + (lane >> 5);
        float v = wv[i];
        if (ks) v *= ks[k0 + kk];
        scr[kk * 33 + n] = v;
    }
    asm volatile("s_waitcnt lgkmcnt(0)" ::: "memory");
    const int c = lane & 7;
#pragma unroll
    for (int j = 0; j < 4; ++j) {
        const int nn = (lane >> 3) + 8 * j; const float* s = scr + (8 * c) * 33 + nn;
        u32x4 o; o.x = pk2(s[0 * 33], s[1 * 33]); o.y = pk2(s[2 * 33], s[3 * 33]); o.z = pk2(s[4 * 33], s[5 * 33]); o.w = pk2(s[6 * 33], s[7 * 33]);
        *(u32x4*)(dst + (size_t)(dst_row0 + nn) * dstK + k0 + 8 * c) = o;
    }
    asm volatile("s_waitcnt lgkmcnt(0)" ::: "memory");
}

__device__ __forceinline__ void phase_weights(const Args& a, int l, unsigned char* lds, int gw, int ngw, int wave, int lane) {
    float* scr = (float*)(lds + wave * 16384);
    unsigned char* W = a.ws + WS_W;
    constexpr int I_IN = 16 * 176, I_UPA = 8 * 32, I_UPR = 16 * 32, I_OUT = 16 * 32, I_1 = 16 * 128, I_2 = 64 * 32, I_C1 = 32 * 8, I_C2 = 4 * 2, I_L = 16 * 2;
    constexpr int NITEMS = I_IN + I_UPA + I_UPR + I_OUT + I_1 + I_2 + 2 * I_C1 + 2 * I_C2 + 2 * I_L;
    for (int it = gw; it < NITEMS; it += ngw) {
        int r = it;
        if (r < I_IN) {
            const int kb = r / 176, nb = r % 176, n0 = nb * 32;
            int src, nv;
            if (n0 < 1280) { src = n0; nv = 32; } else if (n0 < 5376) { src = n0 + 24; nv = 32; } else if (n0 == 5376) { src = 1280; nv = 24; } else { src = 0; nv = 0; }
            tr_item(a.in[2] + (size_t)l * DM * DIN, DIN, kb * 64, src, nv, a.in[1] + l * DM, (bf16_t*)(W + W_IN), 1024, n0, scr, lane); continue;
        }
        r -= I_IN;
        if (r < I_UPA) { tr_item(a.in[16] + (size_t)l * 512 * 1024, 1024, (r / 32) * 64, (r % 32) * 32, 32, nullptr, (bf16_t*)(W + W_UPA), 512, (r % 32) * 32, scr, lane); continue; }
        r -= I_UPA;
        if (r < I_UPR) { tr_item(a.in[17] + (size_t)l * 1024 * 1024, 1024, (r / 32) * 64, (r % 32) * 32, 32, nullptr, (bf16_t*)(W + W_UPR), 1024, (r % 32) * 32, scr, lane); continue; }
        r -= I_UPR;
        if (r < I_OUT) { tr_item(a.in[18] + (size_t)l * 1024 * 1024, 1024, (r / 32) * 64, (r % 32) * 32, 32, nullptr, (bf16_t*)(W + W_OUT), 1024, (r % 32) * 32, scr, lane); continue; }
        r -= I_OUT;
        if (r < I_1) { tr_item(a.in[20] + (size_t)l * 1024 * 4096, 4096, (r / 128) * 64, (r % 128) * 32, 32, a.in[19] + l * DM, (bf16_t*)(W + W_1), 1024, (r % 128) * 32, scr, lane); continue; }
        r -= I_1;
        if (r < I_2) { tr_item(a.in[21] + (size_t)l * 4096 * 1024, 1024, (r / 32) * 64, (r % 32) * 32, 32, nullptr, (bf16_t*)(W + W_2), 4096, (r % 32) * 32, scr, lane); continue; }
        r -= I_2;
        if (r < I_C1) { tr_item(a.in[5] + (size_t)l * 2048 * 256, 256, (r / 8) * 64, (r % 8) * 32, 32, nullptr, (bf16_t*)(W + W_CK1), 2048, (r % 8) * 32, scr, lane); continue; }
        r -= I_C1;
        if (r < I_C1) { tr_item(a.in[7] + (size_t)l * 2048 * 256, 256, (r / 8) * 64, (r % 8) * 32, 32, nullptr, (bf16_t*)(W + W_CV1), 2048, (r % 8) * 32, scr, lane); continue; }
        r -= I_C1;
        if (r < I_C2) { tr_item(a.in[6] + (size_t)l * 256 * 64, 64, (r / 2) * 64, (r % 2) * 32, 32, nullptr, (bf16_t*)(W + W_CK2), 256, (r % 2) * 32, scr, lane); continue; }
        r -= I_C2;
        if (r < I_C2) { tr_item(a.in[8] + (size_t)l * 256 * 64, 64, (r / 2) * 64, (r % 2) * 32, 32, nullptr, (bf16_t*)(W + W_CV2), 256, (r % 2) * 32, scr, lane); continue; }
        r -= I_C2;
        if (r < I_L) { const int h = r / 2; tr_item(a.in[11] + (size_t)l * 65536 + h * 4096, 64, 0, (r % 2) * 32, 32, nullptr, (bf16_t*)(W + W_A) + h * 4096, 64, (r % 2) * 32, scr, lane); continue; }
        r -= I_L;
        { const int h = r / 2; tr_item(a.in[13] + (size_t)l * 65536 + h * 4096, 64, 0, (r % 2) * 32, 32, nullptr, (bf16_t*)(W + W_I) + h * 4096, 64, (r % 2) * 32, scr, lane); }
    }
}

__device__ __forceinline__ void phase_x0(const Args& a, int gw, int ngw, int lane) {
    const float* x = a.in[0]; bf16_t* XB = (bf16_t*)(a.ws + WS_XB); float* ssq = (float*)(a.ws + WS_SSQ);
    for (int row0 = gw; row0 < TOK; row0 += 2 * ngw) {
        f32x4 v[2][4]; float sq[2];
#pragma unroll
        for (int u = 0; u < 2; ++u) { const int row = row0 + u * ngw; const f32x4* xr = (const f32x4*)(x + (size_t)row * DM) + lane;
#pragma unroll
            for (int j = 0; j < 4; ++j) v[u][j] = __builtin_nontemporal_load(xr + 64 * j); }
#pragma unroll
        for (int u = 0; u < 2; ++u) { float s_ = 0.f;
#pragma unroll
            for (int j = 0; j < 4; ++j) s_ += (v[u][j].x * v[u][j].x + v[u][j].y * v[u][j].y) + (v[u][j].z * v[u][j].z + v[u][j].w * v[u][j].w);
            sq[u] = wave_sum(s_); }
#pragma unroll
        for (int u = 0; u < 2; ++u) { const int row = row0 + u * ngw;
            u32x2* bo = (u32x2*)(XB + (size_t)row * DM) + lane;
#pragma unroll
            for (int j = 0; j < 4; ++j) { u32x2 w; w.x = pk2(v[u][j].x, v[u][j].y); w.y = pk2(v[u][j].z, v[u][j].w); bo[64 * j] = w; }
            if (lane < 16) ssq[(size_t)row * 16 + lane] = (lane == 0) ? sq[u] : 0.f; }
    }
}
__device__ __forceinline__ void phase_final(const Args& a, int gw, int ngw, int lane) {
    float* X = a.out; const bf16_t* XB = (const bf16_t*)(a.ws + WS_XB); const float* ssq = (const float*)(a.ws + WS_SSQ) + (size_t)4 * TOK * 16; const float* w = a.in[22];
    f32x4 wv[4];
#pragma unroll
    for (int j = 0; j < 4; ++j) wv[j] = ((const f32x4*)w)[lane + 64 * j];
    for (int row = gw; row < TOK; row += ngw) {
        const float rs = rstd_from_ssq(ssq + (size_t)row * 16);
        const u32x2* xi = (const u32x2*)(XB + (size_t)row * DM) + lane; f32x4* xo = (f32x4*)(X + (size_t)row * DM) + lane;
#pragma unroll
        for (int j = 0; j < 4; ++j) { const u32x2 q = xi[64 * j]; const f32x4 v = (f32x4){bflo(q.x), bfhi(q.x), bflo(q.y), bfhi(q.y)}; xo[64 * j] = v * rs * wv[j]; }
    }
}

__device__ __forceinline__ void vt_phase(const Args& a, unsigned char* lds, int tid, int bid, int G) {
    const int wid = tid >> 6, lane = tid & 63;
    const bf16_t* Z = (const bf16_t*)(a.ws + WS_Z); bf16_t* VT = (bf16_t*)(a.ws + WS_VT);
    bf16_t* T = (bf16_t*)(lds + wid * 9216);
#pragma unroll 1
    for (int item = bid * 8 + wid; item < 1024; item += G * 8) {
        const int tb = item & 63, g = (item >> 6) & 1, kind = (item >> 7) & 1, b = item >> 8;
        u32x4 v[8];
#pragma unroll
        for (int i = 0; i < 8; ++i) { const int q = lane + 64 * i, row = q >> 3, ch = q & 7;
            v[i] = *(const u32x4*)(Z + (size_t)(b * SEQ + tb * 64 + row) * LDZ + (kind ? ZVW : ZVS) + g * 64 + ch * 8); }
#pragma unroll
        for (int i = 0; i < 8; ++i) { const int q = lane + 64 * i, row = q >> 3, ch = q & 7; const unsigned vv[4] = {v[i].x, v[i].y, v[i].z, v[i].w};
#pragma unroll
            for (int e = 0; e < 4; ++e) { T[(ch * 8 + 2 * e) * 72 + row] = (bf16_t)(vv[e] & 0xffffu); T[(ch * 8 + 2 * e + 1) * 72 + row] = (bf16_t)(vv[e] >> 16); } }
        asm volatile("s_waitcnt lgkmcnt(0)" ::: "memory");
#pragma unroll
        for (int i = 0; i < 8; ++i) { const int q = lane + 64 * i, row = q >> 3, ch = q & 7;
            const u32x4 o = *(const u32x4*)(T + row * 72 + ch * 8);
            *(u32x4*)(VT + ((size_t)((b * 2 + kind) * 2 + g) * 64 + row) * SEQ + tb * 64 + ch * 8) = o; }
        asm volatile("s_waitcnt lgkmcnt(0)" ::: "memory");
    }
    __syncthreads();
}

__device__ __forceinline__ void cmp_item(const Args& a, int l, int item, unsigned char* lds, int tid) {
    const int wid = tid >> 6, lane = tid & 63, fr = lane & 15, fq = lane >> 4;
    const int nct = item & 15, g = (item >> 4) & 1, b = (item >> 5) & 3, kv = item >> 7;
    const int nc0 = nct * 16;
    const bf16_t* Z = (const bf16_t*)(a.ws + WS_Z);
    const bf16_t* W1 = (const bf16_t*)(a.ws + WS_W + (kv ? W_CV1 : W_CK1));
    const bf16_t* W2 = (const bf16_t*)(a.ws + WS_W + (kv ? W_CV2 : W_CK2));
    const float* pos = (kv ? a.in[4] : a.in[3]) + (size_t)l * 2048;
    bf16_t* hid = (bf16_t*)lds;
    const int nc = nc0 + fr; const bool rowok = nc < 255;
    const bf16_t* arow = Z + (size_t)(b * SEQ + 16 * (rowok ? nc : 0)) * LDZ + (kv ? ZVC : ZKC) + g * 64;
    const bf16_t* b0 = W1 + (size_t)(32 * wid + fr) * 2048 + 8 * fq;
    const bf16_t* b1 = b0 + (size_t)16 * 2048;
    f32x4 acc0 = {0.f, 0.f, 0.f, 0.f}, acc1 = {0.f, 0.f, 0.f, 0.f};
#pragma unroll 8
    for (int ks = 0; ks < 64; ++ks) {
        const int i = ks >> 1, d = (ks & 1) * 32 + 8 * fq;
        const u32x4 av = *(const u32x4*)(arow + (size_t)i * LDZ + d);
        const f32x4 p0 = *(const f32x4*)(pos + i * 64 + d), p1 = *(const f32x4*)(pos + i * 64 + d + 4);
        u32x4 aw;
        aw.x = pk2(bflo(av.x) + p0.x, bfhi(av.x) + p0.y); aw.y = pk2(bflo(av.y) + p0.z, bfhi(av.y) + p0.w);
        aw.z = pk2(bflo(av.z) + p1.x, bfhi(av.z) + p1.y); aw.w = pk2(bflo(av.w) + p1.z, bfhi(av.w) + p1.w);
        const bf16x8 af = __builtin_bit_cast(bf16x8, aw);
        const bf16x8 bf0 = *(const bf16x8*)(b0 + ks * 32), bf1 = *(const bf16x8*)(b1 + ks * 32);
        acc0 = __builtin_amdgcn_mfma_f32_16x16x32_bf16(af, bf0, acc0, 0, 0, 0);
        acc1 = __builtin_amdgcn_mfma_f32_16x16x32_bf16(af, bf1, acc1, 0, 0, 0);
    }
#pragma unroll
    for (int e = 0; e < 4; ++e) {
        hid[(4 * fq + e) * 264 + 32 * wid + fr] = (bf16_t)f2bf(gelu_tanh(acc0[e]));
        hid[(4 * fq + e) * 264 + 32 * wid + 16 + fr] = (bf16_t)f2bf(gelu_tanh(acc1[e]));
    }
    __syncthreads();
    if (wid < 4) {
        f32x4 acc = {0.f, 0.f, 0.f, 0.f};
        const bf16_t* bw = W2 + (size_t)(16 * wid + fr) * 256 + 8 * fq;
#pragma unroll
        for (int ks = 0; ks < 8; ++ks) {
            const bf16x8 af = *(const bf16x8*)(hid + fr * 264 + ks * 32 + 8 * fq);
            const bf16x8 bf = *(const bf16x8*)(bw + ks * 32);
            acc = __builtin_amdgcn_mfma_f32_16x16x32_bf16(af, bf, acc, 0, 0, 0);
        }
        const int d = 16 * wid + fr;
        float o[4];
#pragma unroll
        for (int e = 0; e < 4; ++e) o[e] = (nc0 + 4 * fq + e < 255) ? acc[e] : 0.f;
        if (kv == 0) {
            bf16_t* KC = (bf16_t*)(a.ws + WS_KC) + (size_t)((b * 2 + g) * 256) * 64;
#pragma unroll
            for (int e = 0; e < 4; ++e) KC[(size_t)(nc0 + 4 * fq + e) * 64 + d] = (bf16_t)f2bf(o[e]);
        } else {
            bf16_t* VCT = (bf16_t*)(a.ws + WS_VCT) + (size_t)((b * 2 + g) * 64) * 256;
            u32x2 w; w.x = pk2(o[0], o[1]); w.y = pk2(o[2], o[3]);
            *(u32x2*)(VCT + (size_t)d * 256 + nc0 + 4 * fq) = w;
        }
    }
    __syncthreads();
}

#define RNN_WLDS 17856
template <int PASS>
__device__ __forceinline__ void rnn_phase(const Args& a, int l, unsigned char* lds, int tid, int bid, int G) {
    const int wid = tid >> 6, lane = tid & 63, fr = lane & 15, fq = lane >> 4;
    const bf16_t* Z = (const bf16_t*)(a.ws + WS_Z);
    float* AGG = (float*)(a.ws + WS_AGG);
    unsigned char* wl = lds + wid * RNN_WLDS;
    unsigned char* gl = wl + 9664;
    const int gwv = bid * 8 + wid, ngwv = G * 8;
#pragma unroll 1
    for (int item = gwv; item < 4096; item += ngwv) {
        const int h = item & 15, cc_ = (item >> 4) & 63, b = item >> 10;
        const int c = (item >= 2048) ? 63 - cc_ : cc_;
        const bf16_t* WA = (const bf16_t*)(a.ws + WS_W + W_A) + h * 4096;
        const bf16_t* WI = (const bf16_t*)(a.ws + WS_W + W_I) + h * 4096;
        u32x4 xv[9];
#pragma unroll
        for (int i = 0; i < 9; ++i) {
            const int q = lane + 64 * i, rr = q >> 3, c8 = q & 7; const int t = c * 64 - 3 + rr;
            xv[i] = (u32x4){0u, 0u, 0u, 0u};
            if (q < 536 && t >= 0) xv[i] = *(const u32x4*)(Z + (size_t)(b * SEQ + t) * LDZ + ZXR + h * 64 + c8 * 8);
        }
        u32x4 gvv[8];
        if (PASS == 2) {
#pragma unroll
            for (int i = 0; i < 8; ++i) { const int q = lane + 64 * i, rr = q >> 3, c8 = q & 7; gvv[i] = *(const u32x4*)(Z + (size_t)(b * SEQ + c * 64 + rr) * LDZ + ZGR + h * 64 + c8 * 8); }
        }
        bf16x8 wa[2], wi[2];
#pragma unroll
        for (int ks = 0; ks < 2; ++ks) { wa[ks] = *(const bf16x8*)(WA + fr * 64 + 32 * ks + 8 * fq); wi[ks] = *(const bf16x8*)(WI + fr * 64 + 32 * ks + 8 * fq); }
        const int cgl0 = h * 64 + lane;
        const float ba_l = a.in[12][l * DM + cgl0], bi_l = a.in[14][l * DM + cgl0], lam_l = a.in[15][l * DM + cgl0];
        float carry = 0.f;
        if (PASS == 2) {
            const float* ap = AGG + ((size_t)(b * 64) * DM + h * 64 + lane) * 2;
#pragma unroll 1
            for (int c0 = 0; c0 < c; c0 += 32) {
                float2 ah[32];
#pragma unroll
                for (int k = 0; k < 32; ++k) { float2 v; v.x = 1.f; v.y = 0.f; if (c0 + k < c) v = *(const float2*)(ap + (size_t)(c0 + k) * DM * 2); ah[k] = v; }
#pragma unroll
                for (int k = 0; k < 32; ++k) carry = ah[k].x * carry + ah[k].y;
            }
        }
        {
            float* pad = (float*)(wl + lane * 144 + 128);
            pad[1] = ba_l; pad[2] = bi_l; pad[3] = -8.0f * log1pf(expf(-lam_l));
        }
#pragma unroll
        for (int i = 0; i < 9; ++i) { const int q = lane + 64 * i, rr = q >> 3, c8 = q & 7; if (q < 536) *(u32x4*)(wl + rr * 144 + c8 * 16) = xv[i]; }
        if (PASS == 2) {
#pragma unroll
            for (int i = 0; i < 8; ++i) { const int q = lane + 64 * i; *(u32x4*)(gl + q * 16) = gvv[i]; }
            *(float*)(wl + lane * 144 + 128) = carry;
        }
        asm volatile("s_waitcnt lgkmcnt(0)" ::: "memory");
        {
            const int cg_ = h * 64 + lane; const float* cw = a.in[9] + (size_t)l * 4 * DM + cg_;
            const float w0 = cw[0], w1 = cw[DM], w2 = cw[2 * DM], w3 = cw[3 * DM], cb = a.in[10][l * DM + cg_];
            const bf16_t* col = (const bf16_t*)wl + lane;
            float x0 = bf2f(col[0]), x1 = bf2f(col[72]), x2 = bf2f(col[144]);
#pragma unroll 8
            for (int tok = 0; tok < 64; ++tok) {
                const float x3 = bf2f(col[(tok + 3) * 72]);
                float xc = cb; xc += x0 * w0; xc += x1 * w1; xc += x2 * w2; xc += x3 * w3;
                ((bf16_t*)wl)[tok * 72 + lane] = (bf16_t)pk2(xc, xc);
                x0 = x1; x1 = x2; x2 = x3;
            }
        }
        asm volatile("s_waitcnt lgkmcnt(0)" ::: "memory");
#pragma unroll 1
        for (int nt = 0; nt < 4; ++nt) {
            const int j = 16 * nt + fr, cg_ = h * 64 + j;
            const float* pd = (const float*)(wl + j * 144 + 128);
            const float ba_ = pd[1], bi_ = pd[2], s8 = pd[3];
            bf16x8 wan[2], win_[2];
            { const int jn = 16 * ((nt + 1) & 3) + fr;
#pragma unroll
              for (int ks = 0; ks < 2; ++ks) { wan[ks] = *(const bf16x8*)(WA + jn * 64 + 32 * ks + 8 * fq); win_[ks] = *(const bf16x8*)(WI + jn * 64 + 32 * ks + 8 * fq); } }
            float Hc = 0.f, Ac = 1.f;
            if (PASS == 2) Hc = *(const float*)(wl + j * 144 + 128);
            bf16_t* op = (bf16_t*)(a.ws + WS_Z) + (size_t)(b * SEQ + c * 64 + 4 * fq) * LDZ + ZGR + cg_;
#pragma unroll
            for (int mt = 0; mt < 4; ++mt) {
                f32x4 ca = {0.f, 0.f, 0.f, 0.f}, ci = {0.f, 0.f, 0.f, 0.f};
#pragma unroll
                for (int ks = 0; ks < 2; ++ks) {
                    const bf16x8 af = *(const bf16x8*)(wl + (16 * mt + fr) * 144 + (32 * ks + 8 * fq) * 2);
                    ca = __builtin_amdgcn_mfma_f32_16x16x32_bf16(af, wa[ks], ca, 0, 0, 0);
                    ci = __builtin_amdgcn_mfma_f32_16x16x32_bf16(af, wi[ks], ci, 0, 0, 0);
                }
                float av[4], bv[4]; float Al = 1.f, Hl = 0.f;
#pragma unroll
                for (int e = 0; e < 4; ++e) {
                    const int tok = 16 * mt + 4 * fq + e;
                    const float xcv = bf2f(((const bf16_t*)wl)[tok * 72 + j]);
                    const float r = __builtin_amdgcn_rcpf(1.0f + __expf(-(ca[e] + ba_))), ig = __builtin_amdgcn_rcpf(1.0f + __expf(-(ci[e] + bi_)));
                    const float log_a = r * s8;
                    av[e] = __expf(log_a);
                    const float x2 = 2.0f * log_a;
                    const float ser = -x2 * (1.0f + x2 * (0.5f + x2 * 0.16666667f));
                    const float dir = 1.0f - av[e] * av[e];
                    const float om = (x2 > -0.0625f) ? ser : dir;
                    bv[e] = __builtin_amdgcn_sqrtf(om) * (ig * xcv);
                    Hl = av[e] * Hl + bv[e]; Al *= av[e];
                }
                { const float A1 = __shfl_up(Al, 16), H1 = __shfl_up(Hl, 16); if (fq >= 1) { Hl = Al * H1 + Hl; Al *= A1; } }
                { const float A1 = __shfl_up(Al, 32), H1 = __shfl_up(Hl, 32); if (fq >= 2) { Hl = Al * H1 + Hl; Al *= A1; } }
                float Ae = __shfl_up(Al, 16), He = __shfl_up(Hl, 16); if (fq == 0) { Ae = 1.f; He = 0.f; }
                const float At = __shfl(Al, fr + 48), Ht = __shfl(Hl, fr + 48);
                if (PASS == 2) {
                    float hcur = Ae * Hc + He;
#pragma unroll
                    for (int e = 0; e < 4; ++e) {
                        hcur = av[e] * hcur + bv[e];
                        const float gate = bf2f(((const bf16_t*)gl)[(16 * mt + 4 * fq + e) * 64 + j]);
                        const float ov = hcur * gelu_tanh(gate);
                        op[(size_t)(16 * mt + e) * LDZ] = (bf16_t)pk2(ov, ov);
                    }
                }
                Hc = At * Hc + Ht; Ac *= At;
            }
            if (PASS == 1 && fq == 0) { float2 o; o.x = Ac; o.y = Hc; *(float2*)(AGG + ((size_t)(b * 64 + c) * DM + cg_) * 2) = o; }
#pragma unroll
            for (int ks = 0; ks < 2; ++ks) { wa[ks] = wan[ks]; wi[ks] = win_[ks]; }
        }
        asm volatile("s_waitcnt lgkmcnt(0)" ::: "memory");
    }
    __syncthreads();
}

constexpr int AL_K = 0, AL_V = 18432, AL_PS = 36864, AL_IMP = 103424, AL_SEL = 119808;
constexpr int AL_K4 = 0, AL_V4 = 103424;
constexpr int PSLD = 260;
constexpr float NEGF = -1e30f;

__device__ __forceinline__ float dpp_xor1(float v) { return __builtin_bit_cast(float, __builtin_amdgcn_mov_dpp(__builtin_bit_cast(int, v), 0xB1, 0xF, 0xF, true)); }
__device__ __forceinline__ float dpp_xor2(float v) { return __builtin_bit_cast(float, __builtin_amdgcn_mov_dpp(__builtin_bit_cast(int, v), 0x4E, 0xF, 0xF, true)); }
__device__ __forceinline__ float halfmax32(float v) { auto r = __builtin_amdgcn_permlane32_swap(__builtin_bit_cast(unsigned, v), __builtin_bit_cast(unsigned, v), false, false); return fmaxf(__builtin_bit_cast(float, (unsigned)r[0]), __builtin_bit_cast(float, (unsigned)r[1])); }
template <int MODE, bool keymask>
__device__ __forceinline__ void attn_tile_k(const unsigned char* Kt, const unsigned char* Vt, const bf16x8 (&qr)[4], int lo, int hi, bool rowon, float& m, float& l, float inv,
                                          f32x16& o0, f32x16& o1, float* psrow, int lane) {
    const int r = lane & 31, hh = lane >> 5;
    f32x16 p[2];
    bf16x8 kf[8]; u32x2 vlo[8], vhi[8];
#pragma unroll
    for (int i = 0; i < 8; ++i) kf[i] = *(const bf16x8*)(Kt + (32 * (i >> 2) + r) * 144 + (16 * (i & 3) + 8 * hh) * 2);
    if (MODE != 0) {
#pragma unroll
        for (int i = 0; i < 8; ++i) { const int s_ = i >> 1, dt = i & 1; const unsigned char* vp = Vt + (32 * dt + r) * 136 + (16 * s_ + 4 * hh) * 2; vlo[i] = *(const u32x2*)vp; vhi[i] = *(const u32x2*)(vp + 16); }
    }
    __builtin_amdgcn_sched_barrier(0);
    __builtin_amdgcn_s_setprio(1);
#pragma unroll
    for (int kt = 0; kt < 2; ++kt) {
        f32x16 acc = {};
#pragma unroll
        for (int s = 0; s < 4; ++s) acc = __builtin_amdgcn_mfma_f32_32x32x16_bf16(kf[4 * kt + s], qr[s], acc, 0, 0, 0);
        p[kt] = acc;
    }
    __builtin_amdgcn_s_setprio(0);
    if (keymask) {
        const int lo2 = lo - 4 * hh, hi2 = hi - 4 * hh;
#pragma unroll
        for (int kt = 0; kt < 2; ++kt)
#pragma unroll
            for (int rg = 0; rg < 16; ++rg) { const int kc = 32 * kt + (rg & 3) + 8 * (rg >> 2); if (kc < lo2 || kc > hi2) p[kt][rg] = NEGF; }
    }
    float mn = m;
    if (MODE != 1) {
        float t0 = fmaxf(p[0][0], p[1][0]), t1 = fmaxf(p[0][1], p[1][1]);
#pragma unroll
        for (int rg = 2; rg < 16; rg += 2) { t0 = __builtin_fmaxf(__builtin_fmaxf(t0, p[0][rg]), p[1][rg]); t1 = __builtin_fmaxf(__builtin_fmaxf(t1, p[0][rg + 1]), p[1][rg + 1]); }
        float tm = fmaxf(t0, t1);
        if (!rowon) tm = NEGF;
        tm = halfmax32(tm);
        mn = fmaxf(m, tm);
        const float alpha = __builtin_amdgcn_exp2f(m - mn);
        l *= alpha;
        if (MODE == 2) { if (!__all(alpha == 1.0f)) { o0 = o0 * alpha; o1 = o1 * alpha; } }
        m = mn;
    }
    const float mexp = rowon ? mn : 1e30f;
    float sum0 = 0.f, sum1 = 0.f;
    if (keymask) {
#pragma unroll
        for (int kt = 0; kt < 2; ++kt)
#pragma unroll
            for (int rg = 0; rg < 16; ++rg) {
                const float s = p[kt][rg];
                const float e = (s > -1e29f) ? __builtin_amdgcn_exp2f(s - mexp) : 0.f;
                p[kt][rg] = e; if (rg & 1) sum1 += e; else sum0 += e;
            }
    } else {
#pragma unroll
        for (int kt = 0; kt < 2; ++kt)
#pragma unroll
            for (int rg = 0; rg < 16; ++rg) {
                const float e = __builtin_amdgcn_exp2f(p[kt][rg] - mexp);
                p[kt][rg] = e; if (rg & 1) sum1 += e; else sum0 += e;
            }
    }
    if (MODE != 1) l += sum0 + sum1;
    if (MODE == 0) return;
    if (MODE == 1) {
        float* psrow2 = psrow + 4 * hh;
#pragma unroll
        for (int kt = 0; kt < 2; ++kt)
#pragma unroll
            for (int rg = 0; rg < 16; ++rg) {
                const float e = p[kt][rg] * inv; p[kt][rg] = e;
                float v = e; v += dpp_xor1(v); v += dpp_xor2(v);
                if ((lane & 3) == 0) psrow2[32 * kt + (rg & 3) + 8 * (rg >> 2)] = v;
            }
    }
#pragma unroll
    for (int s = 0; s < 4; ++s) {
        const int kt = s >> 1, rb = 8 * (s & 1);
        u32x4 pw;
        pw.x = pk2(p[kt][rb + 0], p[kt][rb + 1]); pw.y = pk2(p[kt][rb + 2], p[kt][rb + 3]); pw.z = pk2(p[kt][rb + 4], p[kt][rb + 5]); pw.w = pk2(p[kt][rb + 6], p[kt][rb + 7]);
        const bf16x8 pf = __builtin_bit_cast(bf16x8, pw);
#pragma unroll
        for (int dt = 0; dt < 2; ++dt) {
            u32x4 vw; vw.x = vlo[2 * s + dt].x; vw.y = vlo[2 * s + dt].y; vw.z = vhi[2 * s + dt].x; vw.w = vhi[2 * s + dt].y;
            const bf16x8 vf = __builtin_bit_cast(bf16x8, vw);
            if (dt == 0) o0 = __builtin_amdgcn_mfma_f32_32x32x16_bf16(vf, pf, o0, 0, 0, 0);
            else o1 = __builtin_amdgcn_mfma_f32_32x32x16_bf16(vf, pf, o1, 0, 0, 0);
        }
    }
}

__device__ __forceinline__ void att2_softmax(f32x16 (&p)[2], bool km, int lo, int hi, bool rowon, float& m, float& l, float& alpha, u32x4 (&pw)[4], int hh) {
    if (km) {
        const int lo2 = lo - 4 * hh, hi2 = hi - 4 * hh;
#pragma unroll
        for (int kt = 0; kt < 2; ++kt)
#pragma unroll
            for (int rg = 0; rg < 16; ++rg) { const int kc = 32 * kt + (rg & 3) + 8 * (rg >> 2); if (kc < lo2 || kc > hi2) p[kt][rg] = -INFINITY; }
    }
    float t0 = fmaxf(p[0][0], p[1][0]), t1 = fmaxf(p[0][1], p[1][1]);
#pragma unroll
    for (int rg = 2; rg < 16; rg += 2) { t0 = __builtin_fmaxf(__builtin_fmaxf(t0, p[0][rg]), p[1][rg]); t1 = __builtin_fmaxf(__builtin_fmaxf(t1, p[0][rg + 1]), p[1][rg + 1]); }
    float tm = fmaxf(t0, t1);
    if (!rowon) tm = NEGF;
    tm = halfmax32(tm);
    const float mn = fmaxf(m, tm);
    alpha = __builtin_amdgcn_exp2f(m - mn);
    m = mn;
    const float mexp = rowon ? mn : 1e30f;
    float sum0 = 0.f, sum1 = 0.f;
#pragma unroll
    for (int kt = 0; kt < 2; ++kt)
#pragma unroll
        for (int rg = 0; rg < 16; ++rg) { const float e = __builtin_amdgcn_exp2f(p[kt][rg] - mexp); p[kt][rg] = e; if (rg & 1) sum1 += e; else sum0 += e; }
    l = l * alpha + (sum0 + sum1);
#pragma unroll
    for (int s = 0; s < 4; ++s) { const int kt = s >> 1, rb = 8 * (s & 1);
        pw[s].x = pk2(p[kt][rb + 0], p[kt][rb + 1]); pw[s].y = pk2(p[kt][rb + 2], p[kt][rb + 3]); pw[s].z = pk2(p[kt][rb + 4], p[kt][rb + 5]); pw[s].w = pk2(p[kt][rb + 6], p[kt][rb + 7]); }
}
__device__ __forceinline__ void attn_tile2(const unsigned char* KtA, const unsigned char* VtA, const unsigned char* KtB, const unsigned char* VtB, const bf16x8 (&qr)[4],
                                           bool kmA, int loA, int hiA, bool rowonA, bool kmB, int loB, int hiB, bool rowonB, float& m, float& l, f32x16& o0, f32x16& o1, int lane) {
    const int r = lane & 31, hh = lane >> 5;
    f32x16 pA[2], pB[2]; bf16x8 kf[8]; u32x2 vlo[8], vhi[8]; u32x4 pw[4]; float alpha;
#define A2_LDK(Kt) do { _Pragma("unroll") for (int i = 0; i < 8; ++i) kf[i] = *(const bf16x8*)((Kt) + (32 * (i >> 2) + r) * 144 + (16 * (i & 3) + 8 * hh) * 2); } while (0)
#define A2_LDV(Vt) do { _Pragma("unroll") for (int i = 0; i < 8; ++i) { const int s_ = i >> 1, dt = i & 1; const unsigned char* vp = (Vt) + (32 * dt + r) * 136 + (16 * s_ + 4 * hh) * 2; vlo[i] = *(const u32x2*)vp; vhi[i] = *(const u32x2*)(vp + 16); } } while (0)
#define A2_QK(P) do { __builtin_amdgcn_s_setprio(1); _Pragma("unroll") for (int kt = 0; kt < 2; ++kt) { f32x16 acc = {}; _Pragma("unroll") for (int s = 0; s < 4; ++s) acc = __builtin_amdgcn_mfma_f32_32x32x16_bf16(kf[4 * kt + s], qr[s], acc, 0, 0, 0); P[kt] = acc; } __builtin_amdgcn_s_setprio(0); } while (0)
#define A2_PV() do { _Pragma("unroll") for (int s = 0; s < 4; ++s) { const bf16x8 pf = __builtin_bit_cast(bf16x8, pw[s]); _Pragma("unroll") for (int dt = 0; dt < 2; ++dt) { \
        u32x4 vw; vw.x = vlo[2 * s + dt].x; vw.y = vlo[2 * s + dt].y; vw.z = vhi[2 * s + dt].x; vw.w = vhi[2 * s + dt].y; const bf16x8 vf = __builtin_bit_cast(bf16x8, vw); \
        if (dt == 0) o0 = __builtin_amdgcn_mfma_f32_32x32x16_bf16(vf, pf, o0, 0, 0, 0); else o1 = __builtin_amdgcn_mfma_f32_32x32x16_bf16(vf, pf, o1, 0, 0, 0); } } } while (0)
    A2_LDK(KtA);
    __builtin_amdgcn_sched_barrier(0);
    A2_QK(pA);
    A2_LDK(KtB); A2_LDV(VtA);
    __builtin_amdgcn_sched_barrier(0);
    A2_QK(pB);
    att2_softmax(pA, kmA, loA, hiA, rowonA, m, l, alpha, pw, hh);
    if (!__all(alpha == 1.0f)) { o0 = o0 * alpha; o1 = o1 * alpha; }
    A2_PV();
    __builtin_amdgcn_sched_barrier(0);
    A2_LDV(VtB);
    att2_softmax(pB, kmB, loB, hiB, rowonB, m, l, alpha, pw, hh);
    if (!__all(alpha == 1.0f)) { o0 = o0 * alpha; o1 = o1 * alpha; }
    A2_PV();
#undef A2_LDK
#undef A2_LDV
#undef A2_QK
#undef A2_PV
}

template <int MODE>
__device__ __forceinline__ void attn_tile(const unsigned char* Kt, const unsigned char* Vt, const bf16x8 (&qr)[4], bool keymask, int lo, int hi, bool rowon, float& m, float& l, float inv,
                                          f32x16& o0, f32x16& o1, float* psrow, int lane) {
    if (keymask) attn_tile_k<MODE, true>(Kt, Vt, qr, lo, hi, rowon, m, l, inv, o0, o1, psrow, lane);
    else attn_tile_k<MODE, false>(Kt, Vt, qr, lo, hi, rowon, m, l, inv, o0, o1, psrow, lane);
}

__device__ __forceinline__ void attn_unit(const Args& a, int b, int g, int qt, unsigned char* lds, int tid) {
    const int wid = tid >> 6, lane = tid & 63, hh = lane >> 5;
    const int tokl = (lane & 31) >> 2, head = lane & 3, ti = 8 * wid + tokl, t0 = 64 * qt, t = t0 + ti;
    const unsigned char* zb = a.ws + WS_Z + (size_t)b * SEQ * LDZ * 2 + (size_t)g * 128;
    const unsigned char* kcb = a.ws + WS_KC + (size_t)((b * 2 + g) * 256) * 128;
    const unsigned char* vcb = a.ws + WS_VCT + (size_t)((b * 2 + g) * 64) * 512;
    const unsigned char* vtsb = a.ws + WS_VT + ((size_t)((b * 2 + 0) * 2 + g) * 64) * SEQ * 2;
    const unsigned char* vtwb = a.ws + WS_VT + ((size_t)((b * 2 + 1) * 2 + g) * 64) * SEQ * 2;
    float* PS = (float*)(lds + AL_PS); float* IMP = (float*)(lds + AL_IMP); unsigned long long* SEL = (unsigned long long*)(lds + AL_SEL);
    unsigned char* qrow = a.ws + WS_Z + ((size_t)(b * SEQ + t) * LDZ + ZQ + (g * 4 + head) * 64) * 2;
    bf16x8 qr[4];
#pragma unroll
    for (int s = 0; s < 4; ++s) qr[s] = *(const bf16x8*)(qrow + (16 * s + 8 * hh) * 2);
    float g0, g1, g2;
    { const float* gn = (const float*)(a.ws + WS_GN) + (size_t)(b * SEQ + t) * 32 + (g * 4 + head) * 3; g0 = gn[0]; g1 = gn[1]; g2 = gn[2]; }
    f32x16 out0 = {}, out1 = {};
    const int srow = tid >> 3, sch = tid & 7;
    const unsigned sdst = srow * 144 + sch * 16, vdst = srow * 136 + sch * 16;
    const unsigned zoff = (unsigned)srow * (LDZ * 2) + sch * 16;
    const unsigned vtoff = (unsigned)srow * (SEQ * 2) + sch * 16;
    u32x4 kreg, vreg, kregA, vregA, kregB, vregB;
#define LBAR() do { asm volatile("s_waitcnt lgkmcnt(0)" ::: "memory"); __builtin_amdgcn_s_barrier(); asm volatile("" ::: "memory"); } while (0)
#define ST_STORE_R(buf, kr, vr) do { *(u32x4*)(lds + AL_K + (buf) * 9216 + sdst) = kr; \
        *(u32x2*)(lds + AL_V + (buf) * 9216 + vdst) = (u32x2){vr.x, vr.y}; *(u32x2*)(lds + AL_V + (buf) * 9216 + vdst + 8) = (u32x2){vr.z, vr.w}; } while (0)
#define ST_STORE(buf) ST_STORE_R(buf, kreg, vreg)
#define ST_STORE4(buf, kr, vr) do { *(u32x4*)(lds + AL_K4 + (buf) * 9216 + sdst) = kr; \
        *(u32x2*)(lds + AL_V4 + (buf) * 9216 + vdst) = (u32x2){vr.x, vr.y}; *(u32x2*)(lds + AL_V4 + (buf) * 9216 + vdst + 8) = (u32x2){vr.z, vr.w}; } while (0)
#define RING_PUT(i) do { if ((i) & 1) { kregB = kreg; vregB = vreg; } else { kregA = kreg; vregA = vreg; } } while (0)
#define RING_GET(i) do { if ((i) & 1) { kreg = kregB; vreg = vregB; } else { kreg = kregA; vreg = vregA; } } while (0)

    const int nct = (4 * qt + 66) >> 6;
    const int nmax = (t >= 31) ? ((t - 31) >> 4) : -1;
    float m = NEGF, l = 0.f; f32x16 o0 = {}, o1 = {};
#define CMP_LOAD(c) do { kreg = *(const u32x4*)(kcb + (unsigned)((c) * 8192 + srow * 128 + sch * 16)); vreg = *(const u32x4*)(vcb + (unsigned)(srow * 512 + (c) * 128 + sch * 16)); } while (0)
    CMP_LOAD(0); ST_STORE(0); __syncthreads();
    for (int c = 0; c < nct; ++c) {
        if (c + 1 < nct) CMP_LOAD(c + 1);
        const int hi = nmax - 64 * c;
        attn_tile<0>(lds + AL_K + (c & 1) * 9216, lds + AL_V + (c & 1) * 9216, qr, !__all(hi >= 63), 0, hi, true, m, l, 0.f, o0, o1, nullptr, lane);
        if (c + 1 < nct) ST_STORE((c + 1) & 1);
        LBAR();
    }
    {
        const float lt = l + __shfl_xor(l, 32);
        const float inv = lt > 0.f ? 1.0f / lt : 0.f;
        CMP_LOAD(0); ST_STORE(0); __syncthreads();
        for (int c = 0; c < nct; ++c) {
            if (c + 1 < nct) CMP_LOAD(c + 1);
            const int hi = nmax - 64 * c;
            attn_tile<1>(lds + AL_K + (c & 1) * 9216, lds + AL_V + (c & 1) * 9216, qr, !__all(hi >= 63), 0, hi, true, m, l, inv, o0, o1, PS + ti * PSLD + 64 * c, lane);
            if (c + 1 < nct) ST_STORE((c + 1) & 1);
            LBAR();
        }
        out0 = o0 * g0; out1 = o1 * g0;
    }
    if (qt < 16) {
        if (tid < 64) SEL[tid] = (qt == 63) ? ~0ull : ((1ull << (qt + 1)) - 1ull);
    } else {
#pragma unroll 1
        for (int k = 0; k < 8; ++k) {
            const int tk = 8 * wid + k; const float* pr = PS + tk * PSLD; const int j = lane;
            float v = -1.f;
            if (j >= 1 && j <= qt - 2) { const float p0 = pr[4 * j], p1 = pr[4 * j - 1], p2 = pr[4 * j - 2], p3 = pr[4 * j - 3], p4 = pr[4 * j - 4];
                v = ((((((p0 + p1) + p1) + p2) + p2) + p3) + p3) + p4; }
            IMP[tk * 64 + j] = v;
        }
        __syncthreads();
#pragma unroll 1
        for (int k = 0; k < 8; ++k) {
            const int tk = 8 * wid + k; const int j = lane; const float mine = IMP[tk * 64 + j];
            const f32x4* row = (const f32x4*)(IMP + tk * 64);
            int cnt = 0;
#pragma unroll 4
            for (int q4 = 0; q4 < 16; ++q4) {
                const f32x4 v = row[q4]; const int jb = 4 * q4;
                cnt += ((v.x > mine) || (v.x == mine && jb + 0 < j)) ? 1 : 0;
                cnt += ((v.y > mine) || (v.y == mine && jb + 1 < j)) ? 1 : 0;
                cnt += ((v.z > mine) || (v.z == mine && jb + 2 < j)) ? 1 : 0;
                cnt += ((v.w > mine) || (v.w == mine && jb + 3 < j)) ? 1 : 0;
            }
            const bool sel = (j >= 1 && j <= qt - 2 && cnt < 13) || j == 0 || j == qt - 1 || j == qt;
            const unsigned long long mk = __ballot(sel);
            if (lane == 0) SEL[tk] = mk;
        }
    }
    __syncthreads();
    const unsigned long long mysel = SEL[ti];
    unsigned wlo = (unsigned)mysel, whi = (unsigned)(mysel >> 32);
#pragma unroll
    for (int o = 4; o < 32; o <<= 1) { wlo |= __shfl_xor(wlo, o); whi |= __shfl_xor(whi, o); }
    const unsigned long long wsel = (unsigned long long)__builtin_amdgcn_readfirstlane(wlo) | ((unsigned long long)__builtin_amdgcn_readfirstlane(whi) << 32);

    float* stash = PS + wid * 2048 + lane;
#pragma unroll
    for (int rg = 0; rg < 16; ++rg) { stash[rg * 64] = out0[rg]; stash[(16 + rg) * 64] = out1[rg]; }
    __syncthreads();
#define KV_LOAD_TO(kr, vr, KOFF, vtb, j) do { kr = *(const u32x4*)(zb + ((unsigned)(j) * (64u * LDZ * 2u) + zoff + (KOFF) * 2u)); vr = *(const u32x4*)((vtb) + ((unsigned)(j) * 128u + vtoff)); } while (0)
#define KV_LOAD(KOFF, vtb, j) KV_LOAD_TO(kreg, vreg, KOFF, vtb, j)
#define KV_LOAD_RING(i, KOFF, vtb, j) do { if ((i) & 1) KV_LOAD_TO(kregB, vregB, KOFF, vtb, j); else KV_LOAD_TO(kregA, vregA, KOFF, vtb, j); } while (0)
    {
        m = NEGF; l = 0.f; o0 = (f32x16){}; o1 = (f32x16){};
        const int j0 = qt >= 8 ? qt - 8 : 0, nj = qt - j0 + 1;
        KV_LOAD_TO(kregA, vregA, ZKW, vtwb, j0); KV_LOAD_TO(kregB, vregB, ZKW, vtwb, (nj > 1) ? j0 + 1 : j0);
        ST_STORE4(0, kregA, vregA); ST_STORE4(1, kregB, vregB);
        __syncthreads();
        const int nst = (nj + 1) >> 1;
        for (int st = 0; st < nst; ++st) {
            const int pb = (st & 1) * 2, ia = 2 * st, ib = ia + 1;
            KV_LOAD_TO(kregA, vregA, ZKW, vtwb, j0 + ((ia + 2 < nj) ? ia + 2 : ia)); KV_LOAD_TO(kregB, vregB, ZKW, vtwb, j0 + ((ia + 3 < nj) ? ia + 3 : ia));
            { const int ja_ = j0 + ia, jb_ = j0 + ib;
              const int loa = (ja_ == qt - 8) ? ti + 1 : 0, hia = (ja_ == qt) ? ti : 63, lob = (jb_ == qt - 8) ? ti + 1 : 0, hib = (jb_ == qt) ? ti : 63;
              if (ib < nj) attn_tile2(lds + AL_K4 + pb * 9216, lds + AL_V4 + pb * 9216, lds + AL_K4 + (pb + 1) * 9216, lds + AL_V4 + (pb + 1) * 9216, qr,
                                      (ja_ == qt - 8) || (ja_ == qt), loa, hia, true, (jb_ == qt - 8) || (jb_ == qt), lob, hib, true, m, l, o0, o1, lane);
              else attn_tile<2>(lds + AL_K4 + pb * 9216, lds + AL_V4 + pb * 9216, qr, (ja_ == qt - 8) || (ja_ == qt), loa, hia, true, m, l, 0.f, o0, o1, nullptr, lane); }
            if (ia + 2 < nj) { ST_STORE4(2 - pb, kregA, vregA); ST_STORE4(3 - pb, kregB, vregB); }
            LBAR();
        }
        const float lt = l + __shfl_xor(l, 32);
        const float sc = lt > 0.f ? g2 / lt : 0.f;
#pragma unroll
        for (int rg = 0; rg < 16; ++rg) { stash[rg * 64] += o0[rg] * sc; stash[(16 + rg) * 64] += o1[rg] * sc; }
    }
    {
        m = NEGF; l = 0.f; o0 = (f32x16){}; o1 = (f32x16){};
        const int nj = qt + 1;
        KV_LOAD_TO(kregA, vregA, ZKS, vtsb, 0); KV_LOAD_TO(kregB, vregB, ZKS, vtsb, (nj > 1) ? 1 : 0);
        ST_STORE4(0, kregA, vregA); ST_STORE4(1, kregB, vregB);
        __syncthreads();
        const int nst = (nj + 1) >> 1;
        for (int st = 0; st < nst; ++st) {
            const int pb = (st & 1) * 2, ja = 2 * st, jb = ja + 1;
            KV_LOAD_TO(kregA, vregA, ZKS, vtsb, (ja + 2 < nj) ? ja + 2 : ja); KV_LOAD_TO(kregB, vregB, ZKS, vtsb, (ja + 3 < nj) ? ja + 3 : ja);
#ifndef PROBE_SLC_SKIP
            { const bool ona = ((wsel >> ja) & 1ull) != 0ull, onb = jb < nj && ((wsel >> jb) & 1ull) != 0ull;
              if (ona && onb) attn_tile2(lds + AL_K4 + pb * 9216, lds + AL_V4 + pb * 9216, lds + AL_K4 + (pb + 1) * 9216, lds + AL_V4 + (pb + 1) * 9216, qr,
                                         ja == qt, 0, ti, ((mysel >> ja) & 1ull) != 0ull, jb == qt, 0, ti, ((mysel >> jb) & 1ull) != 0ull, m, l, o0, o1, lane);
              else if (ona) attn_tile<2>(lds + AL_K4 + pb * 9216, lds + AL_V4 + pb * 9216, qr, ja == qt, 0, ti, ((mysel >> ja) & 1ull) != 0ull, m, l, 0.f, o0, o1, nullptr, lane);
              else if (onb) attn_tile<2>(lds + AL_K4 + (pb + 1) * 9216, lds + AL_V4 + (pb + 1) * 9216, qr, jb == qt, 0, ti, ((mysel >> jb) & 1ull) != 0ull, m, l, 0.f, o0, o1, nullptr, lane); }
#endif
            if (ja + 2 < nj) { ST_STORE4(2 - pb, kregA, vregA); ST_STORE4(3 - pb, kregB, vregB); }
            LBAR();
        }
        const float lt = l + __shfl_xor(l, 32);
        const float sc = lt > 0.f ? g1 / lt : 0.f;
#pragma unroll
        for (int rg = 0; rg < 16; ++rg) { out0[rg] = stash[rg * 64] + o0[rg] * sc; out1[rg] = stash[(16 + rg) * 64] + o1[rg] * sc; }
    }
    unsigned char* orow = qrow;
#pragma unroll
    for (int rg = 0; rg < 4; ++rg) {
        u32x2 w0; w0.x = pk2(out0[4 * rg], out0[4 * rg + 1]); w0.y = pk2(out0[4 * rg + 2], out0[4 * rg + 3]);
        *(u32x2*)(orow + (8 * rg + 4 * hh) * 2) = w0;
        u32x2 w1; w1.x = pk2(out1[4 * rg], out1[4 * rg + 1]); w1.y = pk2(out1[4 * rg + 2], out1[4 * rg + 3]);
        *(u32x2*)(orow + (32 + 8 * rg + 4 * hh) * 2) = w1;
    }
#undef ST_STORE
#undef ST_STORE4
#undef LBAR
#undef ST_STORE_R
#undef RING_PUT
#undef RING_GET
#undef CMP_LOAD
#undef KV_LOAD
#undef KV_LOAD_TO
#undef KV_LOAD_RING
}

#define GAS __attribute__((address_space(1)))
#define LAS __attribute__((address_space(3)))
typedef GAS unsigned gu32;
typedef GAS unsigned long long gu64;
#define RLX_AGENT __ATOMIC_RELAXED, __HIP_MEMORY_SCOPE_AGENT
#define LDS_WAIT() asm volatile("s_waitcnt lgkmcnt(0)" ::: "memory")
#define VM_WAIT() asm volatile("s_waitcnt vmcnt(0)" ::: "memory")
__device__ __forceinline__ unsigned long long rt() { return __builtin_amdgcn_s_memrealtime(); }
#define XB_TMO      128
#define XB_XCNT(j)  (256  + 64 * (j))
#define XB_XSUB(j)  (1280 + 64 * (j))
#define XB_XGEN(j)  (2304 + 64 * (j))
#define XB_TOP      3328
#define XB_TOPGEN   3392
#define XCD_BAR_WORDS 3456
#define XB_SPIN_CAP (1u << 18)

__device__ __forceinline__ unsigned xb_ld(unsigned* p)              { return __hip_atomic_load(p, __ATOMIC_RELAXED, __HIP_MEMORY_SCOPE_AGENT); }
__device__ __forceinline__ unsigned xb_add(unsigned* p, unsigned v) { return __hip_atomic_fetch_add(p, v, __ATOMIC_RELAXED, __HIP_MEMORY_SCOPE_AGENT); }
__device__ __forceinline__ unsigned xb_xcc_id() { return (unsigned)__builtin_amdgcn_s_getreg((3 << 11) | 20) & 0xFu; }
#define XB_SPIN(cond, bar) do { unsigned _sp = 0; while (cond) { __builtin_amdgcn_s_sleep(1); \
    if ((++_sp & 255u) == 0u) { if (xb_ld(&(bar)[XB_TMO])) break; if (_sp > XB_SPIN_CAP) { atomicAdd(&(bar)[XB_TMO], 1u); break; } } } } while (0)

struct XcdBarrier {
    unsigned* bar; unsigned x;
    volatile LAS unsigned* st;
};

__device__ __forceinline__ XcdBarrier xcd_barrier_post(unsigned* bar, volatile LAS unsigned* st) {
    XcdBarrier b; b.bar = bar; b.x = xb_xcc_id(); b.st = st;
    if (threadIdx.x == 0) (void)xb_add(&bar[XB_XCNT(b.x)], 1u);
    return b;
}
__device__ __forceinline__ void xcd_barrier_complete(unsigned* bar, unsigned x, unsigned& nloc, unsigned& nx) {
    const unsigned G = gridDim.x * gridDim.y * gridDim.z;
    unsigned sum, cnt, mine, sp = 0u;
    for (;;) {
        sum = 0u; cnt = 0u; mine = 0u;
#pragma unroll
        for (unsigned j = 0; j < 16; ++j) { const unsigned c = xb_ld(&bar[XB_XCNT(j)]); sum += c; cnt += (c > 0u) ? 1u : 0u; mine = (j == x) ? c : mine; }
        if (sum == G) break;
        __builtin_amdgcn_s_sleep(1);
        if ((++sp & 255u) == 0u) { if (xb_ld(&bar[XB_TMO])) break; if (sp > XB_SPIN_CAP) { atomicAdd(&bar[XB_TMO], 1u); break; } }
    }
    nloc = mine > 0u ? mine : 1u; nx = cnt > 0u ? cnt : 1u;
}

__device__ __forceinline__ void xcd_barrier(const XcdBarrier& b) {
    asm volatile("s_waitcnt vmcnt(0)" ::: "memory");
    __syncthreads();
    if (threadIdx.x == 0) {
        unsigned* bar = b.bar;
        __builtin_amdgcn_s_waitcnt(0);
        unsigned nloc = b.st[0], nx = b.st[1];
        if (nloc == 0u) { xcd_barrier_complete(bar, b.x, nloc, nx); b.st[0] = nloc; b.st[1] = nx; }
        const unsigned old = xb_add(&bar[XB_XSUB(b.x)], 1u);
        const unsigned gen = old / nloc;
        if (old + 1u == (gen + 1u) * nloc) {
            __builtin_amdgcn_fence(__ATOMIC_RELEASE, "agent");
            asm volatile("s_waitcnt vmcnt(0)" ::: "memory");
            const unsigned og = xb_add(&bar[XB_TOP], 1u);
            const unsigned tg = og / nx;
            if (og + 1u == (tg + 1u) * nx) xb_add(&bar[XB_TOPGEN], 1u);
            else XB_SPIN(xb_ld(&bar[XB_TOPGEN]) == tg, bar);
            __builtin_amdgcn_fence(__ATOMIC_ACQUIRE, "agent");
            xb_add(&bar[XB_XGEN(b.x)], 1u);
            asm volatile("s_waitcnt vmcnt(0)" ::: "memory");
        } else {
            XB_SPIN(xb_ld(&bar[XB_XGEN(b.x)]) == gen, bar);
            __builtin_amdgcn_fence(__ATOMIC_ACQUIRE, "agent");
            asm volatile("s_waitcnt vmcnt(0)" ::: "memory");
        }
    }
    __syncthreads();
}

struct EpiResFinal {
    static constexpr bool PERM = false, AFTER_DRAIN = false;
    const bf16_t* XB; float* X; float* ssq; const float* w; XcdBarrier bar;
    __device__ __forceinline__ void operator()(f32x4 (&acc)[2][2][4][2], const pg8::Unit& u, int wr, int wc, int fr, int fq) const {
        const int row0 = u.pm * 256 + wr * 64 + fr;
        const int col0 = u.pn * 256 + wc * 32 + 4 * fq;
#pragma unroll
        for (int ai = 0; ai < 2; ++ai)
#pragma unroll
            for (int m = 0; m < 4; ++m) {
                const int row = row0 + ai * 128 + m * 16;
                float ss = 0.f;
                asm volatile("" ::: "memory");
#pragma unroll
                for (int bj = 0; bj < 2; ++bj)
#pragma unroll
                    for (int n = 0; n < 2; ++n) {
                        const size_t off = (size_t)row * DM + col0 + bj * 128 + n * 16;
                        const u32x2 xo = *(const u32x2*)(XB + off);
                        const f32x4 v = (f32x4){bflo(xo.x), bfhi(xo.x), bflo(xo.y), bfhi(xo.y)} + acc[ai][bj][m][n];
                        acc[ai][bj][m][n] = v;
                        ss += (v.x * v.x + v.y * v.y) + (v.z * v.z + v.w * v.w);
                    }
                ss += __shfl_xor(ss, 16); ss += __shfl_xor(ss, 32);
                if (fq == 0) ssq[(size_t)row * 16 + u.pn * 4 + wc] = ss;
            }
        xcd_barrier(bar);
#pragma unroll
        for (int ai = 0; ai < 2; ++ai)
#pragma unroll
            for (int m = 0; m < 4; ++m) {
                const int row = row0 + ai * 128 + m * 16;
                asm volatile("" ::: "memory");
                const float rstd = rstd_from_ssq(ssq + (size_t)row * 16);
#pragma unroll
                for (int bj = 0; bj < 2; ++bj)
#pragma unroll
                    for (int n = 0; n < 2; ++n) {
                        const int col = col0 + bj * 128 + n * 16;
                        const f32x4 wv = *(const f32x4*)(w + col);
                        *(f32x4*)(X + (size_t)row * DM + col) = acc[ai][bj][m][n] * rstd * wv;
                    }
            }
    }
};

__global__ void __launch_bounds__(NTHREADS, 2) nsa_fwd(Args a_unused) {
    extern __shared__ __attribute__((aligned(16))) unsigned char lds[];
    cg::grid_group grid = cg::this_grid();
    const int G0 = gridDim.x, bid0 = blockIdx.x;
    const int wave_s = __builtin_amdgcn_readfirstlane(threadIdx.x >> 6);
    PG8_LAS unsigned char* lds3 = (PG8_LAS unsigned char*)lds;
    volatile LAS unsigned* bst = (volatile LAS unsigned*)(lds3 + (LDS_BYTES - 64));
    if (threadIdx.x < 2) bst[threadIdx.x] = 0u;
    __syncthreads();
    XcdBarrier xbar;
    { const Args a = load_args(); xbar = xcd_barrier_post((unsigned*)(a.ws + WS_CTL), bst); }
    if (G0 == 0x7fffffff) grid.sync();
#define GRID_SYNC() xcd_barrier(xbar)
#define SIDS() int G = G0, bid = bid0; asm volatile("" : "+s"(G), "+s"(bid))
#define TIDS() SIDS(); const int tid = tid_now(wave_s), lane = tid & 63, wave = __builtin_amdgcn_readfirstlane(tid >> 6), gw = bid * 8 + wave, ngw = G * 8; (void)lane; (void)gw; (void)ngw
#define ZP(a) ((bf16_t*)((a).ws + WS_Z))
#define XBP(a) ((bf16_t*)((a).ws + WS_XB))
#define SSQP(a) ((float*)((a).ws + WS_SSQ))
#define WP(a) ((a).ws + WS_W)
#pragma unroll 1
    for (int l = 0; l < DEPTH; ++l) {
#pragma unroll 1
        for (int rep = 0; rep < REP_P0; ++rep)
        { TIDS(); const Args a = load_args(); phase_weights(a, l, lds, gw, ngw, wave, lane); }
        if (l == 0) { TIDS(); const Args a = load_args(); phase_x0(a, gw, ngw, lane); }
        GRID_SYNC();
#ifdef PROBE_SYNC
#pragma unroll 1
        for (int rep = 0; rep < PROBE_SYNC; ++rep) GRID_SYNC();
#endif
#ifdef PROBE_G1
#pragma unroll 1
        for (int rep = 0; rep < PROBE_G1; ++rep)
#endif
        {
            SIDS(); const Args a = load_args();
            pg8::Gemm gm{XBP(a), (const bf16_t*)(WP(a) + W_IN), TOK, NIN, DM, DM}; pg8::StaticOrder S; S.init(TOK, NIN, G, bid);
            fill_rtab(S, SSQP(a) + (size_t)(2 * l) * TOK * 16, (float*)(lds + RTAB_OFF), tid_now(wave_s));
            EpiIn E{ZP(a), (float*)(a.ws + WS_GN), (bf16_t*)(a.ws + WS_VT), (const float*)(lds + RTAB_OFF), 0};
            pg8::gemm_phase<EpiIn, pg8::StaticOrder, true, true>(lds3, gm, S, E, tid_now(wave_s));
        }
        GRID_SYNC();
#pragma unroll 1
        for (int rep = 0; rep < REP_P2; ++rep) {
        { TIDS(); const Args a = load_args(); for (int it = bid; it < 256; it += G) cmp_item(a, l, it, lds, tid); }
        { TIDS(); const Args a = load_args(); rnn_phase<1>(a, l, lds, tid, bid, G); }
        }
        GRID_SYNC();
#ifdef PROBE_R2
#pragma unroll 1
        for (int rep = 0; rep < PROBE_R2; ++rep)
#endif
        { TIDS(); const Args a = load_args(); rnn_phase<2>(a, l, lds, tid, bid, G); }
        {
            SIDS();
#pragma unroll 1
            for (int u = bid; u < 256; u += G) {
#pragma unroll 1
                for (int h2 = 0; h2 < 2; ++h2) {
                    const int bg = u & 7, s = u >> 3;
                    int b_ = bg >> 1, g_ = bg & 1, qt_ = h2 ? s : 63 - s;
                    asm volatile("" : "+s"(b_), "+s"(g_), "+s"(qt_));
                    const Args a = load_args();
                    attn_unit(a, b_, g_, qt_, lds, tid_now(wave_s));
                }
            }
        }
        GRID_SYNC();
        {
            SIDS(); const Args a = load_args();
            pg8::Gemm gm{ZP(a) + ZQ, (const bf16_t*)(WP(a) + W_UPA), TOK, DM, 512, LDZ}; pg8::StaticOrder S; S.init(TOK, DM, G, bid);
            EpiUp<0> E{ZP(a)};
            pg8::gemm_phase<EpiUp<0>, pg8::StaticOrder, true, true>(lds3, gm, S, E, tid_now(wave_s));
        }
        {
            SIDS(); const Args a = load_args();
            pg8::Gemm gm{ZP(a) + ZGR, (const bf16_t*)(WP(a) + W_UPR), TOK, DM, DM, LDZ}; pg8::StaticOrder S; S.init(TOK, DM, G, bid);
            EpiUp<1> E{ZP(a)};
            pg8::gemm_phase<EpiUp<1>, pg8::StaticOrder, true, true>(lds3, gm, S, E, tid_now(wave_s));
        }
        GRID_SYNC();
        {
            SIDS(); const Args a = load_args();
            pg8::Gemm gm{ZP(a) + ZXR, (const bf16_t*)(WP(a) + W_OUT), TOK, DM, DM, LDZ}; pg8::StaticOrder S; S.init(TOK, DM, G, bid);
            { EpiRes<false> E{nullptr, XBP(a), SSQP(a) + (size_t)(2 * l + 1) * TOK * 16};
                pg8::gemm_phase<EpiRes<false>, pg8::StaticOrder, true, true>(lds3, gm, S, E, tid_now(wave_s)); }
        }
        GRID_SYNC();
#ifdef PROBE_G6
#pragma unroll 1
        for (int rep = 0; rep < PROBE_G6; ++rep)
#endif
        {
            SIDS(); const Args a = load_args();
            pg8::Gemm gm{XBP(a), (const bf16_t*)(WP(a) + W_1), TOK, DFF, DM, DM}; pg8::StaticOrder S; S.init(TOK, DFF, G, bid);
            fill_rtab(S, SSQP(a) + (size_t)(2 * l + 1) * TOK * 16, (float*)(lds + RTAB_OFF), tid_now(wave_s));
            EpiMlpUp E{ZP(a), (const float*)(lds + RTAB_OFF), 0};
            pg8::gemm_phase<EpiMlpUp, pg8::StaticOrder, true, true>(lds3, gm, S, E, tid_now(wave_s));
        }
        GRID_SYNC();
        if (l + 1 < DEPTH) {
            SIDS(); const Args a = load_args();
            pg8::Gemm gm{ZP(a), (const bf16_t*)(WP(a) + W_2), TOK, DM, DFF, DFF}; pg8::StaticOrder S; S.init(TOK, DM, G, bid);
            EpiRes<false> E{nullptr, XBP(a), SSQP(a) + (size_t)(2 * l + 2) * TOK * 16};
            pg8::gemm_phase<EpiRes<false>, pg8::StaticOrder, true, true>(lds3, gm, S, E, tid_now(wave_s));
            GRID_SYNC();
        } else if (G0 == 256) {
            SIDS(); const Args a = load_args();
            pg8::Gemm gm{ZP(a), (const bf16_t*)(WP(a) + W_2), TOK, DM, DFF, DFF}; pg8::StaticOrder S; S.init(TOK, DM, G, bid);
            EpiResFinal E{XBP(a), a.out, SSQP(a) + (size_t)(2 * l + 2) * TOK * 16, a.in[22], xbar};
            pg8::gemm_phase<EpiResFinal, pg8::StaticOrder, true, true>(lds3, gm, S, E, tid_now(wave_s));
        } else {
            { SIDS(); const Args a = load_args();
              pg8::Gemm gm{ZP(a), (const bf16_t*)(WP(a) + W_2), TOK, DM, DFF, DFF}; pg8::StaticOrder S; S.init(TOK, DM, G, bid);
              EpiRes<false> E{nullptr, XBP(a), SSQP(a) + (size_t)(2 * l + 2) * TOK * 16};
              pg8::gemm_phase<EpiRes<false>, pg8::StaticOrder, true, true>(lds3, gm, S, E, tid_now(wave_s)); }
            GRID_SYNC();
            { TIDS(); const Args a = load_args(); phase_final(a, gw, ngw, lane); }
        }
    }
}

extern "C" void kernel_launch(void* const* d_in, const int* in_sizes, int n_in, void* d_out, int out_size, void* d_ws, size_t ws_size, hipStream_t stream) {
    static int grid = 0;
    if (grid == 0) {
        int dev = 0, cus = 0, per_cu = 0;
        hipGetDevice(&dev);
        hipDeviceGetAttribute(&cus, hipDeviceAttributeMultiprocessorCount, dev);
        hipFuncSetAttribute((const void*)nsa_fwd, hipFuncAttributeMaxDynamicSharedMemorySize, LDS_BYTES);
        hipOccupancyMaxActiveBlocksPerMultiprocessor(&per_cu, (const void*)nsa_fwd, NTHREADS, LDS_BYTES);
        if (per_cu < 1) per_cu = 1;
        grid = cus * per_cu;
        if (n_in != 23 || ws_size < WS_END) fprintf(stderr, "kernel_launch: unexpected n_in %d / ws %zu\n", n_in, ws_size);
        fprintf(stderr, "kernel_launch: grid %d (cus %d x %d)\n", grid, cus, per_cu);
    }
    (void)hipMemsetAsync((unsigned char*)d_ws + WS_CTL, 0, 16384, stream);
    Args a{};
    for (int i = 0; i < 23; ++i) a.in[i] = (const float*)d_in[i];
    a.out = (float*)d_out; a.ws = (unsigned char*)d_ws;
    void* args[] = {&a};
    hipError_t e = hipLaunchCooperativeKernel((const void*)nsa_fwd, dim3(grid), dim3(NTHREADS), args, LDS_BYTES, stream);
    if (e != hipSuccess) fprintf(stderr, "cooperative launch failed: %s (grid %d)\n", hipGetErrorString(e), grid);
}
```

```cpp
#include <hip/hip_runtime.h>
#include <hip/hip_cooperative_groups.h>
#include <cstdio>
#include <cstdint>
namespace cg = cooperative_groups;
namespace pg8 {
#define PG8_LAS __attribute__((address_space(3)))
typedef unsigned short bf16_t;
typedef short bf16x8 __attribute__((ext_vector_type(8)));
typedef float f32x4 __attribute__((ext_vector_type(4)));
typedef unsigned u32x4 __attribute__((ext_vector_type(4)));
constexpr int BM = 256, BK = 64, HALF = 128, HTB = HALF * BK * 2  , STAGE_BYTES = 8 * HTB, NXCD = 8, WGM = 8;

__host__ __device__ __forceinline__ int lds_byte(int r, int c) { const int st = (r >> 4) * 2 + (c >> 5), rr = r & 15, cc = c & 31, ob = rr * 64 + cc * 2; return st * 1024 + (ob ^ (((ob >> 9) & 1) << 5)); }
__host__ __device__ __forceinline__ void stage_rc(int b, int& R, int& C) { const int st = b / 1024, sb = b % 1024, swz = sb ^ (((sb >> 9) & 1) << 5); R = (st >> 1) * 16 + swz / 64; C = (st & 1) * 32 + (swz % 64) / 2; }
__host__ __device__ __forceinline__ int perm32(int rho) { const int n = rho >> 4, i = rho & 15; return 8 * (i >> 2) + 4 * n + (i & 3); }

struct Unit { int pm, pn; };
struct Gemm { const bf16_t* A; const bf16_t* Bt; int M, N, K, lda; };

struct StaticOrder {
    int nM, nN, nwg, G, c;
    __host__ __device__ void init(int M, int N, int G_, int c_) { nM = M / BM; nN = N / BM; nwg = nM * nN; G = G_; c = c_; }
    __host__ __device__ bool next(int i, Unit& u) const {
        const long L = (long)i * G + c; if (L >= nwg) return false;
        int wgid = (int)L; { const int q = nwg / NXCD, r = nwg % NXCD, xcd = wgid % NXCD, off = wgid / NXCD; wgid = (xcd < r ? xcd * (q + 1) : r * (q + 1) + (xcd - r) * q) + off; }
        const int nig = WGM * nN, gid = wgid / nig, fm = gid * WGM, gsz = (nM - fm) < WGM ? (nM - fm) : WGM;
        u.pm = fm + ((wgid % nig) % gsz); u.pn = (wgid % nig) / gsz; return true;
    }
    __device__ __forceinline__ void a_ready(const Unit&) const {}
    __device__ __forceinline__ void done(const Unit&) const {}
};

__device__ __forceinline__ unsigned cvt_pk_bf16(float lo, float hi) { unsigned r; asm volatile("v_cvt_pk_bf16_f32 %0, %1, %2" : "=v"(r) : "v"(lo), "v"(hi)); return r; }
typedef float f32x2 __attribute__((ext_vector_type(2)));
template <class Epi, class Sched, bool ALIGN_EPI = false, bool SP2 = false>
__device__ __forceinline__ void gemm_phase(PG8_LAS unsigned char* lds, const Gemm g, const Sched& S, const Epi& E, int tid_in) {
    int tid_ = tid_in; asm volatile("" : "+v"(tid_)); const int tid = tid_, wid = __builtin_amdgcn_readfirstlane(tid >> 6), lane = tid & 63, wr = wid >> 2, wc = wid & 3, fr = lane & 15, fq = lane >> 4;
    const int K = g.K, nt = K / BK;
    unsigned voffA[2], voffB[2];
#pragma unroll
    for (int i = 0; i < 2; ++i) { int R, C; stage_rc(tid * 16 + i * 8192, R, C); const int Rb = Epi::PERM ? ((R & ~31) + perm32(R & 31)) : R;
        voffA[i] = (unsigned)(R * g.lda + C) * 2u; voffB[i] = (unsigned)(Rb * K + C) * 2u; }
    const size_t kstep = (size_t)(BK * 2);
    const size_t hstep = (size_t)HALF * K * 2;
    const size_t tstep = 2 * hstep; const size_t hstepA = (size_t)HALF * g.lda * 2, tstepA = 2 * hstepA;
    const unsigned ldsw = (unsigned)wid * 1024u;
    const int aoff = lds_byte(wr * 64 + fr, fq * 8), boff = lds_byte(wc * 32 + fr, fq * 8);
#define PG8_SA(b, h) (((b) * 2 + (h)) * HTB)
#define PG8_SB(b, h) ((4 + (b) * 2 + (h)) * HTB)
#define PG8_STAGE(bufoff, gbase, voff) do { _Pragma("unroll") for (int _i = 0; _i < 2; ++_i) \
        __builtin_amdgcn_global_load_lds((const unsigned*)((const char*)(gbase) + (voff)[_i]), (PG8_LAS unsigned*)(lds + (bufoff) + ldsw + _i * 8192), 16, 0, 0); } while (0)
#define PG8_LDA(dst, b, h) do { _Pragma("unroll") for (int m = 0; m < 4; ++m) _Pragma("unroll") for (int k = 0; k < 2; ++k) dst[m][k] = *(const PG8_LAS bf16x8*)(lds + PG8_SA(b, h) + aoff + m * 2048 + k * 1024); } while (0)
#define PG8_LDB(dst, b, h) do { _Pragma("unroll") for (int n = 0; n < 2; ++n) _Pragma("unroll") for (int k = 0; k < 2; ++k) dst[n][k] = *(const PG8_LAS bf16x8*)(lds + PG8_SB(b, h) + boff + n * 2048 + k * 1024); } while (0)
#define PG8_MMA(ai, bj, At, Bt) do { __builtin_amdgcn_s_setprio(1); _Pragma("unroll") for (int m = 0; m < 4; ++m) _Pragma("unroll") for (int n = 0; n < 2; ++n) _Pragma("unroll") for (int k = 0; k < 2; ++k) \
        acc[ai][bj][m][n] = __builtin_amdgcn_mfma_f32_16x16x32_bf16(Bt[n][k], At[m][k], acc[ai][bj][m][n], 0, 0, 0); __builtin_amdgcn_s_setprio(0); } while (0)
#define PG8_WAIT_V(n) asm volatile("s_waitcnt vmcnt(" #n ")" ::: "memory")
#define PG8_WAIT_L(n) asm volatile("s_waitcnt lgkmcnt(" #n ")" ::: "memory")
#define PG8_BAR __builtin_amdgcn_s_barrier()
#define PG8_SCHED __builtin_amdgcn_sched_barrier(0)
    Unit cur, nxt; int ui = 0;
    if (!S.next(0, cur)) return;
    f32x4 acc[2][2][4][2];
#pragma unroll
    for (int a = 0; a < 2; ++a)
#pragma unroll
        for (int b = 0; b < 2; ++b)
#pragma unroll
            for (int m = 0; m < 4; ++m)
#pragma unroll
                for (int n = 0; n < 2; ++n) acc[a][b][m][n] = (f32x4){0.f, 0.f, 0.f, 0.f};
    bf16x8 At[4][2], B0[2][2], B1[2][2];
    const char* cA = (const char*)g.A + (size_t)cur.pm * tstepA; const char* cB = (const char*)g.Bt + (size_t)cur.pn * tstep;
    S.a_ready(cur);
    if constexpr (SP2) {
        PG8_STAGE(PG8_SB(0, 0), cB, voffB); PG8_STAGE(PG8_SB(0, 1), cB + hstep, voffB); PG8_STAGE(PG8_SA(0, 0), cA, voffA); PG8_STAGE(PG8_SA(0, 1), cA + hstepA, voffA);
        if (wr == 1) PG8_BAR;
        PG8_WAIT_V(2); PG8_BAR;
        PG8_STAGE(PG8_SB(1, 0), cB + kstep, voffB); PG8_STAGE(PG8_SA(1, 0), cA + kstep, voffA); PG8_STAGE(PG8_SB(1, 1), cB + hstep + kstep, voffB);
        PG8_WAIT_V(6); PG8_BAR;
    } else {
        PG8_STAGE(PG8_SB(0, 0), cB, voffB); PG8_STAGE(PG8_SA(0, 0), cA, voffA); PG8_STAGE(PG8_SB(0, 1), cB + hstep, voffB); PG8_STAGE(PG8_SA(0, 1), cA + hstepA, voffA);
        if (wr == 1) PG8_BAR;
        PG8_WAIT_V(4); PG8_BAR;
        PG8_STAGE(PG8_SB(1, 0), cB + kstep, voffB); PG8_STAGE(PG8_SA(1, 0), cA + kstep, voffA); PG8_STAGE(PG8_SB(1, 1), cB + hstep + kstep, voffB);
        PG8_WAIT_V(6); PG8_BAR;
    }
    for (;;) {
        const bool has_next = S.next(ui + 1, nxt);
        const char* nA = has_next ? (const char*)g.A + (size_t)nxt.pm * tstepA : cA; const char* nB = has_next ? (const char*)g.Bt + (size_t)nxt.pn * tstep : cB;
        for (int t = 0; t < nt; t += 2) {
            const bool last = (t == nt - 2);
            const char* a1 = cA + (size_t)(t + 1) * kstep;
            const char* a2 = last ? nA : cA + (size_t)(t + 2) * kstep; const char* b2 = last ? nB : cB + (size_t)(t + 2) * kstep;
            const char* a3 = a2 + kstep; const char* b3 = b2 + kstep;
            if (last && has_next) S.a_ready(nxt);
            if constexpr (SP2) {
            PG8_LDB(B0, 0, 0); PG8_LDB(B1, 0, 1); PG8_SCHED; PG8_LDA(At, 0, 0); PG8_STAGE(PG8_SA(1, 1), a1 + hstepA, voffA);
            PG8_WAIT_V(8); PG8_WAIT_L(0); PG8_BAR; PG8_MMA(0, 0, At, B0); PG8_MMA(0, 1, At, B1); PG8_BAR; PG8_SCHED;
            PG8_LDA(At, 0, 1); PG8_STAGE(PG8_SB(0, 0), b2, voffB); PG8_STAGE(PG8_SB(0, 1), b2 + hstep, voffB); PG8_STAGE(PG8_SA(0, 0), a2, voffA);
            PG8_WAIT_V(8); PG8_WAIT_L(0); PG8_BAR; PG8_MMA(1, 0, At, B0); PG8_MMA(1, 1, At, B1); PG8_BAR; PG8_SCHED;
            PG8_LDB(B0, 1, 0); PG8_LDB(B1, 1, 1); PG8_SCHED; PG8_LDA(At, 1, 0); PG8_STAGE(PG8_SA(0, 1), a2 + hstepA, voffA);
            PG8_WAIT_V(8); PG8_WAIT_L(0); PG8_BAR; PG8_MMA(0, 0, At, B0); PG8_MMA(0, 1, At, B1); PG8_BAR; PG8_SCHED;
            PG8_LDA(At, 1, 1); PG8_STAGE(PG8_SB(1, 0), b3, voffB); PG8_STAGE(PG8_SB(1, 1), b3 + hstep, voffB); PG8_STAGE(PG8_SA(1, 0), a3, voffA);
            PG8_WAIT_V(8); PG8_WAIT_L(0); PG8_BAR; PG8_MMA(1, 0, At, B0); PG8_MMA(1, 1, At, B1); PG8_BAR; PG8_SCHED;
            } else {
            PG8_LDB(B0, 0, 0); PG8_SCHED; PG8_LDA(At, 0, 0); PG8_STAGE(PG8_SA(1, 1), a1 + hstepA, voffA);
            PG8_WAIT_L(8); PG8_BAR; PG8_WAIT_L(0); PG8_MMA(0, 0, At, B0); PG8_BAR; PG8_SCHED;
            PG8_LDB(B1, 0, 1); PG8_STAGE(PG8_SB(0, 0), b2, voffB);
            PG8_BAR; PG8_WAIT_L(0); PG8_MMA(0, 1, At, B1); PG8_BAR;
            PG8_LDA(At, 0, 1); PG8_STAGE(PG8_SA(0, 0), a2, voffA);
            PG8_BAR; PG8_WAIT_L(0); PG8_MMA(1, 0, At, B0); PG8_BAR; PG8_SCHED;
            PG8_STAGE(PG8_SB(0, 1), b2 + hstep, voffB);
            PG8_WAIT_V(6); PG8_BAR; PG8_MMA(1, 1, At, B1); PG8_BAR;
            PG8_LDB(B0, 1, 0); PG8_SCHED; PG8_LDA(At, 1, 0); PG8_STAGE(PG8_SA(0, 1), a2 + hstepA, voffA);
            PG8_WAIT_L(8); PG8_BAR; PG8_WAIT_L(0); PG8_MMA(0, 0, At, B0); PG8_BAR; PG8_SCHED;
            PG8_LDB(B1, 1, 1); PG8_STAGE(PG8_SB(1, 0), b3, voffB);
            PG8_BAR; PG8_WAIT_L(0); PG8_MMA(0, 1, At, B1); PG8_BAR;
            PG8_LDA(At, 1, 1); PG8_STAGE(PG8_SA(1, 0), a3, voffA);
            PG8_BAR; PG8_WAIT_L(0); PG8_MMA(1, 0, At, B0); PG8_BAR; PG8_SCHED;
            PG8_STAGE(PG8_SB(1, 1), b3 + hstep, voffB);
            PG8_WAIT_V(6); PG8_BAR; PG8_MMA(1, 1, At, B1); PG8_BAR;
            }
        }
        if constexpr (ALIGN_EPI) { if (wr == 0) PG8_BAR; }
        if constexpr (!Epi::AFTER_DRAIN) { E(acc, cur, wr, wc, fr, fq); S.done(cur); }
        if (!has_next) break;
#pragma unroll
        for (int a = 0; a < 2; ++a)
#pragma unroll
            for (int b = 0; b < 2; ++b)
#pragma unroll
                for (int m = 0; m < 4; ++m)
#pragma unroll
                    for (int n = 0; n < 2; ++n) acc[a][b][m][n] = (f32x4){0.f, 0.f, 0.f, 0.f};
        cur = nxt; cA = nA; cB = nB; ++ui;
        if constexpr (ALIGN_EPI) { if (wr == 1) PG8_BAR; }
    }
    PG8_WAIT_V(0);
    if constexpr (!ALIGN_EPI) { if (wr == 0) PG8_BAR; }
    PG8_BAR;
    if constexpr (Epi::AFTER_DRAIN) { E.fused(acc, cur, wr, wc, fr, fq, lds, wid, lane); S.done(cur); }
#undef PG8_SA
#undef PG8_SB
#undef PG8_STAGE
#undef PG8_LDA
#undef PG8_LDB
#undef PG8_MMA
#undef PG8_WAIT_V
#undef PG8_WAIT_L
#undef PG8_BAR
#undef PG8_SCHED
}
}
using pg8::bf16_t; using pg8::bf16x8; using pg8::f32x4; using pg8::u32x4;
typedef float f32x16 __attribute__((ext_vector_type(16)));
typedef unsigned u32x2 __attribute__((ext_vector_type(2)));
typedef short s16x4 __attribute__((ext_vector_type(4)));

constexpr int BATCH = 4, SEQ = 4096, DM = 1024, TOK = BATCH * SEQ, DEPTH = 2, DFF = 4096;
constexpr int LDZ = 5376, NIN = 5632, DIN = 5400;
constexpr int ZQ = 0, ZKC = 512, ZVC = 640, ZKS = 768, ZVS = 896, ZKW = 1024, ZVW = 1152, ZXR = 1280, ZGR = 2304, ZGA = 3328, ZGB = 4352;
constexpr float EPSN = 1e-6f;
constexpr float QSCALE = 0.125f * 1.4426950408889634f;
constexpr int NTHREADS = 512;
#ifndef REP_P0
#define REP_P0 1
#endif
#ifndef REP_P2
#define REP_P2 1
#endif
constexpr int LDS_BYTES = 147456;

constexpr size_t MiB = 1u << 20;
constexpr size_t W_IN = 0, W_UPA = 11 * MiB, W_UPR = 12 * MiB, W_OUT = 14 * MiB, W_1 = 16 * MiB, W_2 = 24 * MiB, W_CK1 = 32 * MiB, W_CV1 = 33 * MiB,
                 W_CK2 = 34 * MiB, W_CV2 = 34 * MiB + 32768, W_A = 34 * MiB + 65536, W_I = 34 * MiB + 65536 + 131072;
constexpr size_t WS_W = 0, WS_Z = 36 * MiB, WS_XB = 204 * MiB, WS_GN = 236 * MiB, WS_SSQ = 238 * MiB, WS_KC = 243 * MiB, WS_VCT = 243 * MiB + 262144,
                 WS_VT = 244 * MiB, WS_AGG = 252 * MiB, WS_CTL = 254 * MiB, WS_END = 254 * MiB + 16384;

struct Args { const float* in[23]; float* out; unsigned char* ws; };
typedef const __attribute__((address_space(4))) Args* ArgsP;
__device__ __forceinline__ int tid_now(int wave_s) { int t; asm volatile("v_mbcnt_lo_u32_b32 %0, -1, 0\n\tv_mbcnt_hi_u32_b32 %0, -1, %0\n\tv_lshl_add_u32 %0, %1, 6, %0" : "=&v"(t) : "s"(wave_s)); return t; }
__device__ __forceinline__ Args load_args() {
    Args r{};
#if defined(__HIP_DEVICE_COMPILE__)
    ArgsP p = (ArgsP)__builtin_amdgcn_kernarg_segment_ptr(); asm volatile("" : "+s"(p));
#pragma unroll
    for (int i = 0; i < 23; ++i) r.in[i] = p->in[i];
    r.out = p->out; r.ws = p->ws;
#endif
    return r;
}

__device__ __forceinline__ unsigned f2bf(float f) { unsigned u = __builtin_bit_cast(unsigned, f); return (u + 0x7fffu + ((u >> 16) & 1u)) >> 16; }
__device__ __forceinline__ unsigned pk2(float lo, float hi) { return pg8::cvt_pk_bf16(lo, hi); }
__device__ __forceinline__ float bf2f(unsigned short v) { return __builtin_bit_cast(float, (unsigned)v << 16); }
__device__ __forceinline__ float bflo(unsigned v) { return __builtin_bit_cast(float, v << 16); }
__device__ __forceinline__ float bfhi(unsigned v) { return __builtin_bit_cast(float, v & 0xffff0000u); }
__device__ __forceinline__ float sigmoidf_(float x) { return __builtin_amdgcn_rcpf(1.0f + __expf(-x)); }
__device__ __forceinline__ float gelu_tanh(float x) {
    const float y = 0.7978845608028654f * (x + 0.044715f * x * x * x);
    const float e = __expf(2.0f * y);
    const float th = 1.0f - 2.0f * __builtin_amdgcn_rcpf(e + 1.0f);
    return 0.5f * x * (1.0f + th);
}
__device__ __forceinline__ float wave_sum(float v) {
#pragma unroll
    for (int o = 1; o < 64; o <<= 1) v += __shfl_xor(v, o);
    return v;
}
__device__ __forceinline__ float rstd_from_ssq(const float* p) {
    const f32x4 a = *(const f32x4*)p, b = *(const f32x4*)(p + 4), c = *(const f32x4*)(p + 8), d = *(const f32x4*)(p + 12);
    const float s = ((a.x + a.y) + (a.z + a.w)) + ((b.x + b.y) + (b.z + b.w)) + ((c.x + c.y) + (c.z + c.w)) + ((d.x + d.y) + (d.z + d.w));
    return rsqrtf(s * (1.0f / 1024.0f) + EPSN);
}

struct EpiIn {
    static constexpr bool PERM = true, AFTER_DRAIN = false;
    bf16_t* Z; float* GN; bf16_t* VT; const float* rtab; mutable int ui;
    __device__ __forceinline__ void operator()(const f32x4 (&acc)[2][2][4][2], const pg8::Unit& u, int wr, int wc, int fr, int fq) const {
        const int row0 = u.pm * 256 + wr * 64 + fr;
        const float* rt = rtab + ui * 256 + wr * 64 + fr; ++ui;
#pragma unroll
        for (int ai = 0; ai < 2; ++ai)
#pragma unroll
            for (int m = 0; m < 4; ++m) {
                const int row = row0 + ai * 128 + m * 16;
                const float rstd = rt[ai * 128 + m * 16];
                asm volatile("" ::: "memory");
                if (u.pn < 21) {
                    const float sc = rstd * (u.pn < 2 ? QSCALE : 1.0f);
                    bf16_t* rowp = Z + (size_t)row * LDZ + u.pn * 256 + wc * 32 + 8 * fq;
#pragma unroll
                    for (int bj = 0; bj < 2; ++bj) {
                        const f32x4 v0 = acc[ai][bj][m][0] * sc, v1 = acc[ai][bj][m][1] * sc;
                        u32x4 w; w.x = pk2(v0[0], v0[1]); w.y = pk2(v0[2], v0[3]); w.z = pk2(v1[0], v1[1]); w.w = pk2(v1[2], v1[3]);
                        if (bj == 1 && (u.pn == 3 || u.pn == 4)) {
                            const int cc = wc * 32 + 8 * fq, g_ = cc >> 6, d0 = cc & 63, b_ = row >> 12, t_ = row & (SEQ - 1);
                            bf16_t* vp = VT + ((size_t)((b_ * 2 + (u.pn - 3)) * 2 + g_) * 64 + d0) * SEQ + t_;
                            const unsigned ww[4] = {w.x, w.y, w.z, w.w};
#pragma unroll
                            for (int e = 0; e < 4; ++e) { vp[(size_t)(2 * e) * SEQ] = (bf16_t)(ww[e] & 0xffffu); vp[(size_t)(2 * e + 1) * SEQ] = (bf16_t)(ww[e] >> 16); }
                        } else *(u32x4*)(rowp + bj * 128) = w;
                    }
                } else if (wc == 0) {
                    float* gp = GN + (size_t)row * 32 + 8 * fq;
#pragma unroll
                    for (int n = 0; n < 2; ++n) {
                        const f32x4 v = acc[ai][0][m][n] * rstd;
                        f32x4 o; o.x = sigmoidf_(v.x); o.y = sigmoidf_(v.y); o.z = sigmoidf_(v.z); o.w = sigmoidf_(v.w);
                        *(f32x4*)(gp + 4 * n) = o;
                    }
                }
            }
    }
};
template <int MODE>
struct EpiUp {
    static constexpr bool PERM = true, AFTER_DRAIN = false;
    bf16_t* Z;
    __device__ __forceinline__ void operator()(const f32x4 (&acc)[2][2][4][2], const pg8::Unit& u, int wr, int wc, int fr, int fq) const {
        const int row0 = u.pm * 256 + wr * 64 + fr;
        const int col0 = u.pn * 256 + wc * 32 + 8 * fq;
#pragma unroll
        for (int ai = 0; ai < 2; ++ai)
#pragma unroll
            for (int m = 0; m < 4; ++m) {
                bf16_t* rowp = Z + (size_t)(row0 + ai * 128 + m * 16) * LDZ + col0;
                asm volatile("" ::: "memory");
#pragma unroll
                for (int bj = 0; bj < 2; ++bj) {
                    const u32x4 gg = *(const u32x4*)(rowp + (MODE == 0 ? ZGA : ZGB) + bj * 128);
                    float g[8] = {bflo(gg.x), bfhi(gg.x), bflo(gg.y), bfhi(gg.y), bflo(gg.z), bfhi(gg.z), bflo(gg.w), bfhi(gg.w)};
                    float v[8];
#pragma unroll
                    for (int e = 0; e < 4; ++e) { v[e] = sigmoidf_(g[e]) * acc[ai][bj][m][0][e]; v[4 + e] = sigmoidf_(g[4 + e]) * acc[ai][bj][m][1][e]; }
                    if (MODE == 1) {
                        const u32x4 tt = *(const u32x4*)(rowp + ZXR + bj * 128);
                        v[0] += bflo(tt.x); v[1] += bfhi(tt.x); v[2] += bflo(tt.y); v[3] += bfhi(tt.y); v[4] += bflo(tt.z); v[5] += bfhi(tt.z); v[6] += bflo(tt.w); v[7] += bfhi(tt.w);
                    }
                    u32x4 w; w.x = pk2(v[0], v[1]); w.y = pk2(v[2], v[3]); w.z = pk2(v[4], v[5]); w.w = pk2(v[6], v[7]);
                    *(u32x4*)(rowp + ZXR + bj * 128) = w;
                }
            }
    }
};
template <bool SRC_F32>
struct EpiRes {
    static constexpr bool PERM = false, AFTER_DRAIN = false;
    const float* Xin; bf16_t* XB; float* ssq;
    __device__ __forceinline__ void operator()(const f32x4 (&acc)[2][2][4][2], const pg8::Unit& u, int wr, int wc, int fr, int fq) const {
        const int row0 = u.pm * 256 + wr * 64 + fr;
        const int col0 = u.pn * 256 + wc * 32 + 4 * fq;
#pragma unroll
        for (int ai = 0; ai < 2; ++ai)
#pragma unroll
            for (int m = 0; m < 4; ++m) {
                const int row = row0 + ai * 128 + m * 16;
                float ss = 0.f;
                asm volatile("" ::: "memory");
#pragma unroll
                for (int bj = 0; bj < 2; ++bj)
#pragma unroll
                    for (int n = 0; n < 2; ++n) {
                        const size_t off = (size_t)row * DM + col0 + bj * 128 + n * 16;
                        f32x4 v;
                        if (SRC_F32) v = *(const f32x4*)(Xin + off);
                        else { const u32x2 xo = *(const u32x2*)(XB + off); v = (f32x4){bflo(xo.x), bfhi(xo.x), bflo(xo.y), bfhi(xo.y)}; }
                        v = v + acc[ai][bj][m][n];
                        u32x2 w; w.x = pk2(v.x, v.y); w.y = pk2(v.z, v.w);
                        *(u32x2*)(XB + off) = w;
                        ss += (v.x * v.x + v.y * v.y) + (v.z * v.z + v.w * v.w);
                    }
                ss += __shfl_xor(ss, 16); ss += __shfl_xor(ss, 32);
                if (fq == 0) ssq[(size_t)row * 16 + u.pn * 4 + wc] = ss;
            }
    }
};
struct EpiMlpUp {
    static constexpr bool PERM = true, AFTER_DRAIN = false;
    bf16_t* H; const float* rtab; mutable int ui;
    __device__ __forceinline__ void operator()(const f32x4 (&acc)[2][2][4][2], const pg8::Unit& u, int wr, int wc, int fr, int fq) const {
        const int row0 = u.pm * 256 + wr * 64 + fr;
        const int col0 = u.pn * 256 + wc * 32 + 8 * fq;
        const float* rt = rtab + ui * 256 + wr * 64 + fr; ++ui;
#pragma unroll
        for (int ai = 0; ai < 2; ++ai)
#pragma unroll
            for (int m = 0; m < 4; ++m) {
                const int row = row0 + ai * 128 + m * 16;
                const float rstd = rt[ai * 128 + m * 16];
                asm volatile("" ::: "memory");
                bf16_t* rowp = H + (size_t)row * DFF + col0;
#pragma unroll
                for (int bj = 0; bj < 2; ++bj) {
                    f32x4 v0 = acc[ai][bj][m][0] * rstd, v1 = acc[ai][bj][m][1] * rstd;
#pragma unroll
                    for (int e = 0; e < 4; ++e) { const float a = fmaxf(v0[e], 0.f), b = fmaxf(v1[e], 0.f); v0[e] = a * a; v1[e] = b * b; }
                    u32x4 w; w.x = pk2(v0[0], v0[1]); w.y = pk2(v0[2], v0[3]); w.z = pk2(v1[0], v1[1]); w.w = pk2(v1[2], v1[3]);
                    *(u32x4*)(rowp + bj * 128) = w;
                }
            }
    }
};

constexpr int RTAB_OFF = 131072;
__device__ __forceinline__ void fill_rtab(const pg8::StaticOrder& S, const float* ssq, float* tab, int tid) {
    pg8::Unit u;
    for (int i = 0; S.next(i, u); ++i)
        if (tid < 256) tab[i * 256 + tid] = rstd_from_ssq(ssq + (size_t)(u.pm * 256 + tid) * 16);
    __syncthreads();
}
__device__ __forceinline__ void tr_item(const float* W, int ldn, int k0, int src_n0, int nvalid, const float* ks, bf16_t* dst, int dstK, int dst_row0, float* scr, int lane) {
    const int n = lane & 31;
    float wv[32];
    const float* wp = W + (size_t)(k0 + (lane >> 5)) * ldn + src_n0 + n;
#pragma unroll
    for (int i = 0; i < 32; ++i) wv[i] = (n < nvalid) ? __builtin_nontemporal_load(wp + (size_t)(2 * i) * ldn) : 0.f;
#pragma unroll
    for (int i = 0; i < 32; ++i) {
        const int kk = 2 * i + (lane >> 5);
        float v = wv[i];
        if (ks) v *= ks[k0 + kk];
        scr[kk * 33 + n] = v;
    }
    asm volatile("s_waitcnt lgkmcnt(0)" ::: "memory");
    const int c = lane & 7;
#pragma unroll
    for (int j = 0; j < 4; ++j) {
        const int nn = (lane >> 3) + 8 * j; const float* s = scr + (8 * c) * 33 + nn;
        u32x4 o; o.x = pk2(s[0 * 33], s[1 * 33]); o.y = pk2(s[2 * 33], s[3 * 33]); o.z = pk2(s[4 * 33], s[5 * 33]); o.w = pk2(s[6 * 33], s[7 * 33]);
        *(u32x4*)(dst + (size_t)(dst_row0 + nn) * dstK + k0 + 8 * c) = o;
    }
    asm volatile("s_waitcnt lgkmcnt(0)" ::: "memory");
}

__device__ __forceinline__ void phase_weights(const Args& a, int l, unsigned char* lds, int gw, int ngw, int wave, int lane) {
    float* scr = (float*)(lds + wave * 16384);
    unsigned char* W = a.ws + WS_W;
    constexpr int I_IN = 16 * 176, I_UPA = 8 * 32, I_UPR = 16 * 32, I_OUT = 16 * 32, I_1 = 16 * 128, I_2 = 64 * 32, I_C1 = 32 * 8, I_C2 = 4 * 2, I_L = 16 * 2;
    constexpr int NITEMS = I_IN + I_UPA + I_UPR + I_OUT + I_1 + I_2 + 2 * I_C1 + 2 * I_C2 + 2 * I_L;
    for (int it = gw; it < NITEMS; it += ngw) {
        int r = it;
        if (r < I_IN) {
            const int kb = r / 176, nb = r % 176, n0 = nb * 32;
            int src, nv;
            if (n0 < 1280) { src = n0; nv = 32; } else if (n0 < 5376) { src = n0 + 24; nv = 32; } else if (n0 == 5376) { src = 1280; nv = 24; } else { src = 0; nv = 0; }
            tr_item(a.in[2] + (size_t)l * DM * DIN, DIN, kb * 64, src, nv, a.in[1] + l * DM, (bf16_t*)(W + W_IN), 1024, n0, scr, lane); continue;
        }
        r -= I_IN;
        if (r < I_UPA) { tr_item(a.in[16] + (size_t)l * 512 * 1024, 1024, (r / 32) * 64, (r % 32) * 32, 32, nullptr, (bf16_t*)(W + W_UPA), 512, (r % 32) * 32, scr, lane); continue; }
        r -= I_UPA;
        if (r < I_UPR) { tr_item(a.in[17] + (size_t)l * 1024 * 1024, 1024, (r / 32) * 64, (r % 32) * 32, 32, nullptr, (bf16_t*)(W + W_UPR), 1024, (r % 32) * 32, scr, lane); continue; }
        r -= I_UPR;
        if (r < I_OUT) { tr_item(a.in[18] + (size_t)l * 1024 * 1024, 1024, (r / 32) * 64, (r % 32) * 32, 32, nullptr, (bf16_t*)(W + W_OUT), 1024, (r % 32) * 32, scr, lane); continue; }
        r -= I_OUT;
        if (r < I_1) { tr_item(a.in[20] + (size_t)l * 1024 * 4096, 4096, (r / 128) * 64, (r % 128) * 32, 32, a.in[19] + l * DM, (bf16_t*)(W + W_1), 1024, (r % 128) * 32, scr, lane); continue; }
        r -= I_1;
        if (r < I_2) { tr_item(a.in[21] + (size_t)l * 4096 * 1024, 1024, (r / 32) * 64, (r % 32) * 32, 32, nullptr, (bf16_t*)(W + W_2), 4096, (r % 32) * 32, scr, lane); continue; }
        r -= I_2;
        if (r < I_C1) { tr_item(a.in[5] + (size_t)l * 2048 * 256, 256, (r / 8) * 64, (r % 8) * 32, 32, nullptr, (bf16_t*)(W + W_CK1), 2048, (r % 8) * 32, scr, lane); continue; }
        r -= I_C1;
        if (r < I_C1) { tr_item(a.in[7] + (size_t)l * 2048 * 256, 256, (r / 8) * 64, (r % 8) * 32, 32, nullptr, (bf16_t*)(W + W_CV1), 2048, (r % 8) * 32, scr, lane); continue; }
        r -= I_C1;
        if (r < I_C2) { tr_item(a.in[6] + (size_t)l * 256 * 64, 64, (r / 2) * 64, (r % 2) * 32, 32, nullptr, (bf16_t*)(W + W_CK2), 256, (r % 2) * 32, scr, lane); continue; }
        r -= I_C2;
        if (r < I_C2) { tr_item(a.in[8] + (size_t)l * 256 * 64, 64, (r / 2) * 64, (r % 2) * 32, 32, nullptr, (bf16_t*)(W + W_CV2), 256, (r % 2) * 32, scr, lane); continue; }
        r -= I_C2;
        if (r < I_L) { const int h = r / 2; tr_item(a.in[11] + (size_t)l * 65536 + h * 4096, 64, 0, (r % 2) * 32, 32, nullptr, (bf16_t*)(W + W_A) + h * 4096, 64, (r % 2) * 32, scr, lane); continue; }
        r -= I_L;
        { const int h = r / 2; tr_item(a.in[13] + (size_t)l * 65536 + h * 4096, 64, 0, (r % 2) * 32, 32, nullptr, (bf16_t*)(W + W_I) + h * 4096, 64, (r % 2) * 32, scr, lane); }
    }
}

__device__ __forceinline__ void phase_x0(const Args& a, int gw, int ngw, int lane) {
    const float* x = a.in[0]; bf16_t* XB = (bf16_t*)(a.ws + WS_XB); float* ssq = (float*)(a.ws + WS_SSQ);
    for (int row0 = gw; row0 < TOK; row0 += 2 * ngw) {
        f32x4 v[2][4]; float sq[2];
#pragma unroll
        for (int u = 0; u < 2; ++u) { const int row = row0 + u * ngw; const f32x4* xr = (const f32x4*)(x + (size_t)row * DM) + lane;
#pragma unroll
            for (int j = 0; j < 4; ++j) v[u][j] = __builtin_nontemporal_load(xr + 64 * j); }
#pragma unroll
        for (int u = 0; u < 2; ++u) { float s_ = 0.f;
#pragma unroll
            for (int j = 0; j < 4; ++j) s_ += (v[u][j].x * v[u][j].x + v[u][j].y * v[u][j].y) + (v[u][j].z * v[u][j].z + v[u][j].w * v[u][j].w);
            sq[u] = wave_sum(s_); }
#pragma unroll
        for (int u = 0; u < 2; ++u) { const int row = row0 + u * ngw;
            u32x2* bo = (u32x2*)(XB + (size_t)row * DM) + lane;
#pragma unroll
            for (int j = 0; j < 4; ++j) { u32x2 w; w.x = pk2(v[u][j].x, v[u][j].y); w.y = pk2(v[u][j].z, v[u][j].w); bo[64 * j] = w; }
            if (lane < 16) ssq[(size_t)row * 16 + lane] = (lane == 0) ? sq[u] : 0.f; }
    }
}
__device__ __forceinline__ void phase_final(const Args& a, int gw, int ngw, int lane) {
    float* X = a.out; const bf16_t* XB = (const bf16_t*)(a.ws + WS_XB); const float* ssq = (const float*)(a.ws + WS_SSQ) + (size_t)4 * TOK * 16; const float* w = a.in[22];
    f32x4 wv[4];
#pragma unroll
    for (int j = 0; j < 4; ++j) wv[j] = ((const f32x4*)w)[lane + 64 * j];
    for (int row = gw; row < TOK; row += ngw) {
        const float rs = rstd_from_ssq(ssq + (size_t)row * 16);
        const u32x2* xi = (const u32x2*)(XB + (size_t)row * DM) + lane; f32x4* xo = (f32x4*)(X + (size_t)row * DM) + lane;
#pragma unroll
        for (int j = 0; j < 4; ++j) { const u32x2 q = xi[64 * j]; const f32x4 v = (f32x4){bflo(q.x), bfhi(q.x), bflo(q.y), bfhi(q.y)}; xo[64 * j] = v * rs * wv[j]; }
    }
}

__device__ __forceinline__ void vt_phase(const Args& a, unsigned char* lds, int tid, int bid, int G) {
    const int wid = tid >> 6, lane = tid & 63;
    const bf16_t* Z = (const bf16_t*)(a.ws + WS_Z); bf16_t* VT = (bf16_t*)(a.ws + WS_VT);
    bf16_t* T = (bf16_t*)(lds + wid * 9216);
#pragma unroll 1
    for (int item = bid * 8 + wid; item < 1024; item += G * 8) {
        const int tb = item & 63, g = (item >> 6) & 1, kind = (item >> 7) & 1, b = item >> 8;
        u32x4 v[8];
#pragma unroll
        for (int i = 0; i < 8; ++i) { const int q = lane + 64 * i, row = q >> 3, ch = q & 7;
            v[i] = *(const u32x4*)(Z + (size_t)(b * SEQ + tb * 64 + row) * LDZ + (kind ? ZVW : ZVS) + g * 64 + ch * 8); }
#pragma unroll
        for (int i = 0; i < 8; ++i) { const int q = lane + 64 * i, row = q >> 3, ch = q & 7; const unsigned vv[4] = {v[i].x, v[i].y, v[i].z, v[i].w};
#pragma unroll
            for (int e = 0; e < 4; ++e) { T[(ch * 8 + 2 * e) * 72 + row] = (bf16_t)(vv[e] & 0xffffu); T[(ch * 8 + 2 * e + 1) * 72 + row] = (bf16_t)(vv[e] >> 16); } }
        asm volatile("s_waitcnt lgkmcnt(0)" ::: "memory");
#pragma unroll
        for (int i = 0; i < 8; ++i) { const int q = lane + 64 * i, row = q >> 3, ch = q & 7;
            const u32x4 o = *(const u32x4*)(T + row * 72 + ch * 8);
            *(u32x4*)(VT + ((size_t)((b * 2 + kind) * 2 + g) * 64 + row) * SEQ + tb * 64 + ch * 8) = o; }
        asm volatile("s_waitcnt lgkmcnt(0)" ::: "memory");
    }
    __syncthreads();
}

__device__ __forceinline__ void cmp_item(const Args& a, int l, int item, unsigned char* lds, int tid) {
    const int wid = tid >> 6, lane = tid & 63, fr = lane & 15, fq = lane >> 4;
    const int nct = item & 15, g = (item >> 4) & 1, b = (item >> 5) & 3, kv = item >> 7;
    const int nc0 = nct * 16;
    const bf16_t* Z = (const bf16_t*)(a.ws + WS_Z);
    const bf16_t* W1 = (const bf16_t*)(a.ws + WS_W + (kv ? W_CV1 : W_CK1));
    const bf16_t* W2 = (const bf16_t*)(a.ws + WS_W + (kv ? W_CV2 : W_CK2));
    const float* pos = (kv ? a.in[4] : a.in[3]) + (size_t)l * 2048;
    bf16_t* hid = (bf16_t*)lds;
    const int nc = nc0 + fr; const bool rowok = nc < 255;
    const bf16_t* arow = Z + (size_t)(b * SEQ + 16 * (rowok ? nc : 0)) * LDZ + (kv ? ZVC : ZKC) + g * 64;
    const bf16_t* b0 = W1 + (size_t)(32 * wid + fr) * 2048 + 8 * fq;
    const bf16_t* b1 = b0 + (size_t)16 * 2048;
    f32x4 acc0 = {0.f, 0.f, 0.f, 0.f}, acc1 = {0.f, 0.f, 0.f, 0.f};
    float* posl = (float*)(lds + 16384);
    *(f32x4*)(posl + tid * 4) = *(const f32x4*)(pos + tid * 4);
    __syncthreads();
#pragma unroll 16
    for (int ks = 0; ks < 64; ++ks) {
        const int i = ks >> 1, d = (ks & 1) * 32 + 8 * fq;
        const u32x4 av = *(const u32x4*)(arow + (size_t)i * LDZ + d);
        const f32x4 p0 = *(const f32x4*)(posl + i * 64 + d), p1 = *(const f32x4*)(posl + i * 64 + d + 4);
        u32x4 aw;
        aw.x = pk2(bflo(av.x) + p0.x, bfhi(av.x) + p0.y); aw.y = pk2(bflo(av.y) + p0.z, bfhi(av.y) + p0.w);
        aw.z = pk2(bflo(av.z) + p1.x, bfhi(av.z) + p1.y); aw.w = pk2(bflo(av.w) + p1.z, bfhi(av.w) + p1.w);
        const bf16x8 af = __builtin_bit_cast(bf16x8, aw);
        const bf16x8 bf0 = *(const bf16x8*)(b0 + ks * 32), bf1 = *(const bf16x8*)(b1 + ks * 32);
        acc0 = __builtin_amdgcn_mfma_f32_16x16x32_bf16(af, bf0, acc0, 0, 0, 0);
        acc1 = __builtin_amdgcn_mfma_f32_16x16x32_bf16(af, bf1, acc1, 0, 0, 0);
    }
#pragma unroll
    for (int e = 0; e < 4; ++e) {
        hid[(4 * fq + e) * 264 + 32 * wid + fr] = (bf16_t)f2bf(gelu_tanh(acc0[e]));
        hid[(4 * fq + e) * 264 + 32 * wid + 16 + fr] = (bf16_t)f2bf(gelu_tanh(acc1[e]));
    }
    __syncthreads();
    if (wid < 4) {
        f32x4 acc = {0.f, 0.f, 0.f, 0.f};
        const bf16_t* bw = W2 + (size_t)(16 * wid + fr) * 256 + 8 * fq;
#pragma unroll
        for (int ks = 0; ks < 8; ++ks) {
            const bf16x8 af = *(const bf16x8*)(hid + fr * 264 + ks * 32 + 8 * fq);
            const bf16x8 bf = *(const bf16x8*)(bw + ks * 32);
            acc = __builtin_amdgcn_mfma_f32_16x16x32_bf16(af, bf, acc, 0, 0, 0);
        }
        const int d = 16 * wid + fr;
        float o[4];
#pragma unroll
        for (int e = 0; e < 4; ++e) o[e] = (nc0 + 4 * fq + e < 255) ? acc[e] : 0.f;
        if (kv == 0) {
            bf16_t* KC = (bf16_t*)(a.ws + WS_KC) + (size_t)((b * 2 + g) * 256) * 64;
#pragma unroll
            for (int e = 0; e < 4; ++e) KC[(size_t)(nc0 + 4 * fq + e) * 64 + d] = (bf16_t)f2bf(o[e]);
        } else {
            bf16_t* VCT = (bf16_t*)(a.ws + WS_VCT) + (size_t)((b * 2 + g) * 64) * 256;
            u32x2 w; w.x = pk2(o[0], o[1]); w.y = pk2(o[2], o[3]);
            *(u32x2*)(VCT + (size_t)d * 256 + nc0 + 4 * fq) = w;
        }
    }
    __syncthreads();
}

#define RNN_WLDS 17856
template <int PASS>
__device__ __forceinline__ void rnn_phase(const Args& a, int l, unsigned char* lds, int tid, int bid, int G) {
    const int wid = tid >> 6, lane = tid & 63, fr = lane & 15, fq = lane >> 4;
    const bf16_t* Z = (const bf16_t*)(a.ws + WS_Z);
    float* AGG = (float*)(a.ws + WS_AGG);
    unsigned char* wl = lds + wid * RNN_WLDS;
    unsigned char* gl = wl + 9664;
    const int gwv = bid * 8 + wid, ngwv = G * 8;
#pragma unroll 1
    for (int item = gwv; item < 4096; item += ngwv) {
        const int h = item & 15, cc_ = (item >> 4) & 63, b = item >> 10;
        const int c = (item >= 2048) ? 63 - cc_ : cc_;
        const bf16_t* WA = (const bf16_t*)(a.ws + WS_W + W_A) + h * 4096;
        const bf16_t* WI = (const bf16_t*)(a.ws + WS_W + W_I) + h * 4096;
        u32x4 xv[9];
#pragma unroll
        for (int i = 0; i < 9; ++i) {
            const int q = lane + 64 * i, rr = q >> 3, c8 = q & 7; const int t = c * 64 - 3 + rr;
            xv[i] = (u32x4){0u, 0u, 0u, 0u};
            if (q < 536 && t >= 0) xv[i] = *(const u32x4*)(Z + (size_t)(b * SEQ + t) * LDZ + ZXR + h * 64 + c8 * 8);
        }
        u32x4 gvv[8];
        if (PASS == 2) {
#pragma unroll
            for (int i = 0; i < 8; ++i) { const int q = lane + 64 * i, rr = q >> 3, c8 = q & 7; gvv[i] = *(const u32x4*)(Z + (size_t)(b * SEQ + c * 64 + rr) * LDZ + ZGR + h * 64 + c8 * 8); }
        }
        bf16x8 wa[2], wi[2];
#pragma unroll
        for (int ks = 0; ks < 2; ++ks) { wa[ks] = *(const bf16x8*)(WA + fr * 64 + 32 * ks + 8 * fq); wi[ks] = *(const bf16x8*)(WI + fr * 64 + 32 * ks + 8 * fq); }
        const int cgl0 = h * 64 + lane;
        float w0, w1, w2, w3, cb;
        { const float* cw = a.in[9] + (size_t)l * 4 * DM + cgl0; w0 = cw[0]; w1 = cw[DM]; w2 = cw[2 * DM]; w3 = cw[3 * DM]; cb = a.in[10][l * DM + cgl0]; }
        const float ba_l = a.in[12][l * DM + cgl0], bi_l = a.in[14][l * DM + cgl0], lam_l = a.in[15][l * DM + cgl0];
        float carry = 0.f;
        if (PASS == 2) {
            const float* ap = AGG + ((size_t)(b * 64) * DM + h * 64 + lane) * 2;
#pragma unroll 1
            for (int c0 = 0; c0 < c; c0 += 16) {
                float2 ah[16];
#pragma unroll
                for (int k = 0; k < 16; ++k) { float2 v; v.x = 1.f; v.y = 0.f; if (c0 + k < c) v = *(const float2*)(ap + (size_t)(c0 + k) * DM * 2); ah[k] = v; }
#pragma unroll
                for (int k = 0; k < 16; ++k) carry = ah[k].x * carry + ah[k].y;
            }
        }
        {
            float* pad = (float*)(wl + lane * 144 + 128);
            pad[1] = ba_l; pad[2] = bi_l; pad[3] = -8.0f * log1pf(expf(-lam_l));
        }
#pragma unroll
        for (int i = 0; i < 9; ++i) { const int q = lane + 64 * i, rr = q >> 3, c8 = q & 7; if (q < 536) *(u32x4*)(wl + rr * 144 + c8 * 16) = xv[i]; }
        if (PASS == 2) {
#pragma unroll
            for (int i = 0; i < 8; ++i) { const int q = lane + 64 * i; *(u32x4*)(gl + q * 16) = gvv[i]; }
            *(float*)(wl + lane * 144 + 128) = carry;
        }
        asm volatile("s_waitcnt lgkmcnt(0)" ::: "memory");
        {
            const bf16_t* col = (const bf16_t*)wl + lane;
            float x0 = bf2f(col[0]), x1 = bf2f(col[72]), x2 = bf2f(col[144]);
#pragma unroll 8
            for (int tok = 0; tok < 64; ++tok) {
                const float x3 = bf2f(col[(tok + 3) * 72]);
                float xc = cb; xc += x0 * w0; xc += x1 * w1; xc += x2 * w2; xc += x3 * w3;
                ((bf16_t*)wl)[tok * 72 + lane] = (bf16_t)pk2(xc, xc);
                x0 = x1; x1 = x2; x2 = x3;
            }
        }
        asm volatile("s_waitcnt lgkmcnt(0)" ::: "memory");
#pragma unroll 1
        for (int nt = 0; nt < 4; ++nt) {
            const int j = 16 * nt + fr, cg_ = h * 64 + j;
            const float* pd = (const float*)(wl + j * 144 + 128);
            const float ba_ = pd[1], bi_ = pd[2], s8 = pd[3];
            bf16x8 wan[2], win_[2];
            { const int jn = 16 * ((nt + 1) & 3) + fr;
#pragma unroll
              for (int ks = 0; ks < 2; ++ks) { wan[ks] = *(const bf16x8*)(WA + jn * 64 + 32 * ks + 8 * fq); win_[ks] = *(const bf16x8*)(WI + jn * 64 + 32 * ks + 8 * fq); } }
            float Hc = 0.f, Ac = 1.f;
            if (PASS == 2) Hc = *(const float*)(wl + j * 144 + 128);
            bf16_t* op = (bf16_t*)(a.ws + WS_Z) + (size_t)(b * SEQ + c * 64 + 4 * fq) * LDZ + ZGR + cg_;
#pragma unroll
            for (int mt = 0; mt < 4; ++mt) {
                f32x4 ca = {0.f, 0.f, 0.f, 0.f}, ci = {0.f, 0.f, 0.f, 0.f};
#pragma unroll
                for (int ks = 0; ks < 2; ++ks) {
                    const bf16x8 af = *(const bf16x8*)(wl + (16 * mt + fr) * 144 + (32 * ks + 8 * fq) * 2);
                    ca = __builtin_amdgcn_mfma_f32_16x16x32_bf16(af, wa[ks], ca, 0, 0, 0);
                    ci = __builtin_amdgcn_mfma_f32_16x16x32_bf16(af, wi[ks], ci, 0, 0, 0);
                }
                float av[4], bv[4]; float Al = 1.f, Hl = 0.f;
#pragma unroll
                for (int e = 0; e < 4; ++e) {
                    const int tok = 16 * mt + 4 * fq + e;
                    const float xcv = bf2f(((const bf16_t*)wl)[tok * 72 + j]);
                    const float r = __builtin_amdgcn_rcpf(1.0f + __expf(-(ca[e] + ba_))), ig = __builtin_amdgcn_rcpf(1.0f + __expf(-(ci[e] + bi_)));
                    const float log_a = r * s8;
                    av[e] = __expf(log_a);
                    const float x2 = 2.0f * log_a;
                    const float ser = -x2 * (1.0f + x2 * (0.5f + x2 * 0.16666667f));
                    const float dir = 1.0f - av[e] * av[e];
                    const float om = (x2 > -0.0625f) ? ser : dir;
                    bv[e] = __builtin_amdgcn_sqrtf(om) * (ig * xcv);
                    Hl = av[e] * Hl + bv[e]; Al *= av[e];
                }
                { const float A1 = __shfl_up(Al, 16), H1 = __shfl_up(Hl, 16); if (fq >= 1) { Hl = Al * H1 + Hl; Al *= A1; } }
                { const float A1 = __shfl_up(Al, 32), H1 = __shfl_up(Hl, 32); if (fq >= 2) { Hl = Al * H1 + Hl; Al *= A1; } }
                float Ae = __shfl_up(Al, 16), He = __shfl_up(Hl, 16); if (fq == 0) { Ae = 1.f; He = 0.f; }
                const float At = __shfl(Al, fr + 48), Ht = __shfl(Hl, fr + 48);
                if (PASS == 2) {
                    float hcur = Ae * Hc + He;
#pragma unroll
                    for (int e = 0; e < 4; ++e) {
                        hcur = av[e] * hcur + bv[e];
                        const float gate = bf2f(((const bf16_t*)gl)[(16 * mt + 4 * fq + e) * 64 + j]);
                        const float ov = hcur * gelu_tanh(gate);
                        op[(size_t)(16 * mt + e) * LDZ] = (bf16_t)pk2(ov, ov);
                    }
                }
                Hc = At * Hc + Ht; Ac *= At;
            }
            if (PASS == 1 && fq == 0) { float2 o; o.x = Ac; o.y = Hc; *(float2*)(AGG + ((size_t)(b * 64 + c) * DM + cg_) * 2) = o; }
#pragma unroll
            for (int ks = 0; ks < 2; ++ks) { wa[ks] = wan[ks]; wi[ks] = win_[ks]; }
        }
        asm volatile("s_waitcnt lgkmcnt(0)" ::: "memory");
    }
    __syncthreads();
}

constexpr int AL_K = 0, AL_V = 18432, AL_PS = 36864, AL_IMP = 103424, AL_SEL = 119808;
constexpr int AL_K4 = 0, AL_V4 = 103424;
constexpr int PSLD = 260;
constexpr float NEGF = -1e30f;

__device__ __forceinline__ float dpp_xor1(float v) { return __builtin_bit_cast(float, __builtin_amdgcn_mov_dpp(__builtin_bit_cast(int, v), 0xB1, 0xF, 0xF, true)); }
__device__ __forceinline__ float dpp_xor2(float v) { return __builtin_bit_cast(float, __builtin_amdgcn_mov_dpp(__builtin_bit_cast(int, v), 0x4E, 0xF, 0xF, true)); }
__device__ __forceinline__ float halfmax32(float v) { auto r = __builtin_amdgcn_permlane32_swap(__builtin_bit_cast(unsigned, v), __builtin_bit_cast(unsigned, v), false, false); return fmaxf(__builtin_bit_cast(float, (unsigned)r[0]), __builtin_bit_cast(float, (unsigned)r[1])); }
template <int MODE, bool keymask>
__device__ __forceinline__ void attn_tile_k(const unsigned char* Kt, const unsigned char* Vt, const bf16x8 (&qr)[4], int lo, int hi, bool rowon, float& m, float& l, float inv,
                                          f32x16& o0, f32x16& o1, float* psrow, int lane) {
    const int r = lane & 31, hh = lane >> 5;
    f32x16 p[2];
    bf16x8 kf[8]; u32x2 vlo[8], vhi[8];
#pragma unroll
    for (int i = 0; i < 8; ++i) kf[i] = *(const bf16x8*)(Kt + (32 * (i >> 2) + r) * 144 + (16 * (i & 3) + 8 * hh) * 2);
    if (MODE != 0) {
#pragma unroll
        for (int i = 0; i < 8; ++i) { const int s_ = i >> 1, dt = i & 1; const unsigned char* vp = Vt + (32 * dt + r) * 136 + (16 * s_ + 4 * hh) * 2; vlo[i] = *(const u32x2*)vp; vhi[i] = *(const u32x2*)(vp + 16); }
    }
    __builtin_amdgcn_sched_barrier(0);
    __builtin_amdgcn_s_setprio(1);
#pragma unroll
    for (int kt = 0; kt < 2; ++kt) {
        f32x16 acc = {};
#pragma unroll
        for (int s = 0; s < 4; ++s) acc = __builtin_amdgcn_mfma_f32_32x32x16_bf16(kf[4 * kt + s], qr[s], acc, 0, 0, 0);
        p[kt] = acc;
    }
    __builtin_amdgcn_s_setprio(0);
    if (keymask) {
        const int lo2 = lo - 4 * hh, hi2 = hi - 4 * hh;
#pragma unroll
        for (int kt = 0; kt < 2; ++kt)
#pragma unroll
            for (int rg = 0; rg < 16; ++rg) { const int kc = 32 * kt + (rg & 3) + 8 * (rg >> 2); if (kc < lo2 || kc > hi2) p[kt][rg] = NEGF; }
    }
    float mn = m;
    if (MODE != 1) {
        float t0 = fmaxf(p[0][0], p[1][0]), t1 = fmaxf(p[0][1], p[1][1]);
#pragma unroll
        for (int rg = 2; rg < 16; rg += 2) { t0 = __builtin_fmaxf(__builtin_fmaxf(t0, p[0][rg]), p[1][rg]); t1 = __builtin_fmaxf(__builtin_fmaxf(t1, p[0][rg + 1]), p[1][rg + 1]); }
        float tm = fmaxf(t0, t1);
        if (!rowon) tm = NEGF;
        tm = halfmax32(tm);
        mn = fmaxf(m, tm);
        const float alpha = __builtin_amdgcn_exp2f(m - mn);
        l *= alpha;
        if (MODE == 2) { if (!__all(alpha == 1.0f)) { o0 = o0 * alpha; o1 = o1 * alpha; } }
        m = mn;
    }
    const float mexp = rowon ? mn : 1e30f;
    float sum0 = 0.f, sum1 = 0.f;
    if (keymask) {
#pragma unroll
        for (int kt = 0; kt < 2; ++kt)
#pragma unroll
            for (int rg = 0; rg < 16; ++rg) {
                const float s = p[kt][rg];
                const float e = (s > -1e29f) ? __builtin_amdgcn_exp2f(s - mexp) : 0.f;
                p[kt][rg] = e; if (rg & 1) sum1 += e; else sum0 += e;
            }
    } else {
#pragma unroll
        for (int kt = 0; kt < 2; ++kt)
#pragma unroll
            for (int rg = 0; rg < 16; ++rg) {
                const float e = __builtin_amdgcn_exp2f(p[kt][rg] - mexp);
                p[kt][rg] = e; if (rg & 1) sum1 += e; else sum0 += e;
            }
    }
    if (MODE != 1) l += sum0 + sum1;
    if (MODE == 0) return;
    if (MODE == 1) {
        float* psrow2 = psrow + 4 * hh;
#pragma unroll
        for (int kt = 0; kt < 2; ++kt)
#pragma unroll
            for (int rg = 0; rg < 16; ++rg) {
                const float e = p[kt][rg] * inv; p[kt][rg] = e;
                float v = e; v += dpp_xor1(v); v += dpp_xor2(v);
                if ((lane & 3) == 0) psrow2[32 * kt + (rg & 3) + 8 * (rg >> 2)] = v;
            }
    }
#pragma unroll
    for (int s = 0; s < 4; ++s) {
        const int kt = s >> 1, rb = 8 * (s & 1);
        u32x4 pw;
        pw.x = pk2(p[kt][rb + 0], p[kt][rb + 1]); pw.y = pk2(p[kt][rb + 2], p[kt][rb + 3]); pw.z = pk2(p[kt][rb + 4], p[kt][rb + 5]); pw.w = pk2(p[kt][rb + 6], p[kt][rb + 7]);
        const bf16x8 pf = __builtin_bit_cast(bf16x8, pw);
#pragma unroll
        for (int dt = 0; dt < 2; ++dt) {
            u32x4 vw; vw.x = vlo[2 * s + dt].x; vw.y = vlo[2 * s + dt].y; vw.z = vhi[2 * s + dt].x; vw.w = vhi[2 * s + dt].y;
            const bf16x8 vf = __builtin_bit_cast(bf16x8, vw);
            if (dt == 0) o0 = __builtin_amdgcn_mfma_f32_32x32x16_bf16(vf, pf, o0, 0, 0, 0);
            else o1 = __builtin_amdgcn_mfma_f32_32x32x16_bf16(vf, pf, o1, 0, 0, 0);
        }
    }
}

__device__ __forceinline__ void att2_softmax(f32x16 (&p)[2], bool km, int lo, int hi, bool rowon, float& m, float& l, float& alpha, u32x4 (&pw)[4], int hh) {
    if (km) {
        const int lo2 = lo - 4 * hh, hi2 = hi - 4 * hh;
#pragma unroll
        for (int kt = 0; kt < 2; ++kt)
#pragma unroll
            for (int rg = 0; rg < 16; ++rg) { const int kc = 32 * kt + (rg & 3) + 8 * (rg >> 2); if (kc < lo2 || kc > hi2) p[kt][rg] = -INFINITY; }
    }
    float t0 = fmaxf(p[0][0], p[1][0]), t1 = fmaxf(p[0][1], p[1][1]);
#pragma unroll
    for (int rg = 2; rg < 16; rg += 2) { t0 = __builtin_fmaxf(__builtin_fmaxf(t0, p[0][rg]), p[1][rg]); t1 = __builtin_fmaxf(__builtin_fmaxf(t1, p[0][rg + 1]), p[1][rg + 1]); }
    float tm = fmaxf(t0, t1);
    if (!rowon) tm = NEGF;
    tm = halfmax32(tm);
    const float mn = fmaxf(m, tm);
    alpha = __builtin_amdgcn_exp2f(m - mn);
    m = mn;
    const float mexp = rowon ? mn : 1e30f;
    float sum0 = 0.f, sum1 = 0.f;
#pragma unroll
    for (int kt = 0; kt < 2; ++kt)
#pragma unroll
        for (int rg = 0; rg < 16; ++rg) { const float e = __builtin_amdgcn_exp2f(p[kt][rg] - mexp); p[kt][rg] = e; if (rg & 1) sum1 += e; else sum0 += e; }
    l = l * alpha + (sum0 + sum1);
#pragma unroll
    for (int s = 0; s < 4; ++s) { const int kt = s >> 1, rb = 8 * (s & 1);
        pw[s].x = pk2(p[kt][rb + 0], p[kt][rb + 1]); pw[s].y = pk2(p[kt][rb + 2], p[kt][rb + 3]); pw[s].z = pk2(p[kt][rb + 4], p[kt][rb + 5]); pw[s].w = pk2(p[kt][rb + 6], p[kt][rb + 7]); }
}
__device__ __forceinline__ void attn_tile2(const unsigned char* KtA, const unsigned char* VtA, const unsigned char* KtB, const unsigned char* VtB, const bf16x8 (&qr)[4],
                                           bool kmA, int loA, int hiA, bool rowonA, bool kmB, int loB, int hiB, bool rowonB, float& m, float& l, f32x16& o0, f32x16& o1, int lane) {
    const int r = lane & 31, hh = lane >> 5;
    f32x16 pA[2], pB[2]; bf16x8 kf[8]; u32x2 vlo[8], vhi[8]; u32x4 pw[4]; float alpha;
#define A2_LDK(Kt) do { _Pragma("unroll") for (int i = 0; i < 8; ++i) kf[i] = *(const bf16x8*)((Kt) + (32 * (i >> 2) + r) * 144 + (16 * (i & 3) + 8 * hh) * 2); } while (0)
#define A2_LDV(Vt) do { _Pragma("unroll") for (int i = 0; i < 8; ++i) { const int s_ = i >> 1, dt = i & 1; const unsigned char* vp = (Vt) + (32 * dt + r) * 136 + (16 * s_ + 4 * hh) * 2; vlo[i] = *(const u32x2*)vp; vhi[i] = *(const u32x2*)(vp + 16); } } while (0)
#define A2_QK(P) do { __builtin_amdgcn_s_setprio(1); _Pragma("unroll") for (int kt = 0; kt < 2; ++kt) { f32x16 acc = {}; _Pragma("unroll") for (int s = 0; s < 4; ++s) acc = __builtin_amdgcn_mfma_f32_32x32x16_bf16(kf[4 * kt + s], qr[s], acc, 0, 0, 0); P[kt] = acc; } __builtin_amdgcn_s_setprio(0); } while (0)
#define A2_PV() do { _Pragma("unroll") for (int s = 0; s < 4; ++s) { const bf16x8 pf = __builtin_bit_cast(bf16x8, pw[s]); _Pragma("unroll") for (int dt = 0; dt < 2; ++dt) { \
        u32x4 vw; vw.x = vlo[2 * s + dt].x; vw.y = vlo[2 * s + dt].y; vw.z = vhi[2 * s + dt].x; vw.w = vhi[2 * s + dt].y; const bf16x8 vf = __builtin_bit_cast(bf16x8, vw); \
        if (dt == 0) o0 = __builtin_amdgcn_mfma_f32_32x32x16_bf16(vf, pf, o0, 0, 0, 0); else o1 = __builtin_amdgcn_mfma_f32_32x32x16_bf16(vf, pf, o1, 0, 0, 0); } } } while (0)
    A2_LDK(KtA);
    __builtin_amdgcn_sched_barrier(0);
    A2_QK(pA);
    A2_LDK(KtB); A2_LDV(VtA);
    __builtin_amdgcn_sched_barrier(0);
    A2_QK(pB);
    att2_softmax(pA, kmA, loA, hiA, rowonA, m, l, alpha, pw, hh);
    if (!__all(alpha == 1.0f)) { o0 = o0 * alpha; o1 = o1 * alpha; }
    A2_PV();
    __builtin_amdgcn_sched_barrier(0);
    A2_LDV(VtB);
    att2_softmax(pB, kmB, loB, hiB, rowonB, m, l, alpha, pw, hh);
    if (!__all(alpha == 1.0f)) { o0 = o0 * alpha; o1 = o1 * alpha; }
    A2_PV();
#undef A2_LDK
#undef A2_LDV
#undef A2_QK
#undef A2_PV
}

template <int MODE>
__device__ __forceinline__ void attn_tile(const unsigned char* Kt, const unsigned char* Vt, const bf16x8 (&qr)[4], bool keymask, int lo, int hi, bool rowon, float& m, float& l, float inv,
                                          f32x16& o0, f32x16& o1, float* psrow, int lane) {
    if (keymask) attn_tile_k<MODE, true>(Kt, Vt, qr, lo, hi, rowon, m, l, inv, o0, o1, psrow, lane);
    else attn_tile_k<MODE, false>(Kt, Vt, qr, lo, hi, rowon, m, l, inv, o0, o1, psrow, lane);
}

__device__ __forceinline__ void attn_unit(const Args& a, int b, int g, int qt, unsigned char* lds, int tid) {
    const int wid = tid >> 6, lane = tid & 63, hh = lane >> 5;
    const int tokl = (lane & 31) >> 2, head = lane & 3, ti = 8 * wid + tokl, t0 = 64 * qt, t = t0 + ti;
    const unsigned char* zb = a.ws + WS_Z + (size_t)b * SEQ * LDZ * 2 + (size_t)g * 128;
    const unsigned char* kcb = a.ws + WS_KC + (size_t)((b * 2 + g) * 256) * 128;
    const unsigned char* vcb = a.ws + WS_VCT + (size_t)((b * 2 + g) * 64) * 512;
    const unsigned char* vtsb = a.ws + WS_VT + ((size_t)((b * 2 + 0) * 2 + g) * 64) * SEQ * 2;
    const unsigned char* vtwb = a.ws + WS_VT + ((size_t)((b * 2 + 1) * 2 + g) * 64) * SEQ * 2;
    float* PS = (float*)(lds + AL_PS); float* IMP = (float*)(lds + AL_IMP); unsigned long long* SEL = (unsigned long long*)(lds + AL_SEL);
    unsigned char* qrow = a.ws + WS_Z + ((size_t)(b * SEQ + t) * LDZ + ZQ + (g * 4 + head) * 64) * 2;
    bf16x8 qr[4];
#pragma unroll
    for (int s = 0; s < 4; ++s) qr[s] = *(const bf16x8*)(qrow + (16 * s + 8 * hh) * 2);
    float g0, g1, g2;
    { const float* gn = (const float*)(a.ws + WS_GN) + (size_t)(b * SEQ + t) * 32 + (g * 4 + head) * 3; g0 = gn[0]; g1 = gn[1]; g2 = gn[2]; }
    f32x16 out0 = {}, out1 = {};
    const int srow = tid >> 3, sch = tid & 7;
    const unsigned sdst = srow * 144 + sch * 16, vdst = srow * 136 + sch * 16;
    const unsigned zoff = (unsigned)srow * (LDZ * 2) + sch * 16;
    const unsigned vtoff = (unsigned)srow * (SEQ * 2) + sch * 16;
    u32x4 kreg, vreg, kregA, vregA, kregB, vregB;
#define LBAR() do { asm volatile("s_waitcnt lgkmcnt(0)" ::: "memory"); __builtin_amdgcn_s_barrier(); asm volatile("" ::: "memory"); } while (0)
#define ST_STORE_R(buf, kr, vr) do { *(u32x4*)(lds + AL_K + (buf) * 9216 + sdst) = kr; \
        *(u32x2*)(lds + AL_V + (buf) * 9216 + vdst) = (u32x2){vr.x, vr.y}; *(u32x2*)(lds + AL_V + (buf) * 9216 + vdst + 8) = (u32x2){vr.z, vr.w}; } while (0)
#define ST_STORE(buf) ST_STORE_R(buf, kreg, vreg)
#define ST_STORE4(buf, kr, vr) do { *(u32x4*)(lds + AL_K4 + (buf) * 9216 + sdst) = kr; \
        *(u32x2*)(lds + AL_V4 + (buf) * 9216 + vdst) = (u32x2){vr.x, vr.y}; *(u32x2*)(lds + AL_V4 + (buf) * 9216 + vdst + 8) = (u32x2){vr.z, vr.w}; } while (0)
#define RING_PUT(i) do { if ((i) & 1) { kregB = kreg; vregB = vreg; } else { kregA = kreg; vregA = vreg; } } while (0)
#define RING_GET(i) do { if ((i) & 1) { kreg = kregB; vreg = vregB; } else { kreg = kregA; vreg = vregA; } } while (0)

    const int nct = (4 * qt + 66) >> 6;
    const int nmax = (t >= 31) ? ((t - 31) >> 4) : -1;
    float m = NEGF, l = 0.f; f32x16 o0 = {}, o1 = {};
#define CMP_LOAD(c) do { kreg = *(const u32x4*)(kcb + (unsigned)((c) * 8192 + srow * 128 + sch * 16)); vreg = *(const u32x4*)(vcb + (unsigned)(srow * 512 + (c) * 128 + sch * 16)); } while (0)
    CMP_LOAD(0); ST_STORE(0); __syncthreads();
    for (int c = 0; c < nct; ++c) {
        if (c + 1 < nct) CMP_LOAD(c + 1);
        const int hi = nmax - 64 * c;
        attn_tile<0>(lds + AL_K + (c & 1) * 9216, lds + AL_V + (c & 1) * 9216, qr, !__all(hi >= 63), 0, hi, true, m, l, 0.f, o0, o1, nullptr, lane);
        if (c + 1 < nct) ST_STORE((c + 1) & 1);
        LBAR();
    }
    {
        const float lt = l + __shfl_xor(l, 32);
        const float inv = lt > 0.f ? 1.0f / lt : 0.f;
        CMP_LOAD(0); ST_STORE(0); __syncthreads();
        for (int c = 0; c < nct; ++c) {
            if (c + 1 < nct) CMP_LOAD(c + 1);
            const int hi = nmax - 64 * c;
            attn_tile<1>(lds + AL_K + (c & 1) * 9216, lds + AL_V + (c & 1) * 9216, qr, !__all(hi >= 63), 0, hi, true, m, l, inv, o0, o1, PS + ti * PSLD + 64 * c, lane);
            if (c + 1 < nct) ST_STORE((c + 1) & 1);
            LBAR();
        }
        out0 = o0 * g0; out1 = o1 * g0;
    }
    if (qt < 16) {
        if (tid < 64) SEL[tid] = (qt == 63) ? ~0ull : ((1ull << (qt + 1)) - 1ull);
    } else {
#pragma unroll 1
        for (int k = 0; k < 8; ++k) {
            const int tk = 8 * wid + k; const float* pr = PS + tk * PSLD; const int j = lane;
            float v = -1.f;
            if (j >= 1 && j <= qt - 2) { const float p0 = pr[4 * j], p1 = pr[4 * j - 1], p2 = pr[4 * j - 2], p3 = pr[4 * j - 3], p4 = pr[4 * j - 4];
                v = ((((((p0 + p1) + p1) + p2) + p2) + p3) + p3) + p4; }
            IMP[tk * 64 + j] = v;
        }
        __syncthreads();
#pragma unroll 1
        for (int k = 0; k < 8; ++k) {
            const int tk = 8 * wid + k; const int j = lane; const float mine = IMP[tk * 64 + j];
            const f32x4* row = (const f32x4*)(IMP + tk * 64);
            int cnt = 0;
#pragma unroll 4
            for (int q4 = 0; q4 < 16; ++q4) {
                const f32x4 v = row[q4]; const int jb = 4 * q4;
                cnt += ((v.x > mine) || (v.x == mine && jb + 0 < j)) ? 1 : 0;
                cnt += ((v.y > mine) || (v.y == mine && jb + 1 < j)) ? 1 : 0;
                cnt += ((v.z > mine) || (v.z == mine && jb + 2 < j)) ? 1 : 0;
                cnt += ((v.w > mine) || (v.w == mine && jb + 3 < j)) ? 1 : 0;
            }
            const bool sel = (j >= 1 && j <= qt - 2 && cnt < 13) || j == 0 || j == qt - 1 || j == qt;
            const unsigned long long mk = __ballot(sel);
            if (lane == 0) SEL[tk] = mk;
        }
    }
    __syncthreads();
    const unsigned long long mysel = SEL[ti];
    unsigned wlo = (unsigned)mysel, whi = (unsigned)(mysel >> 32);
#pragma unroll
    for (int o = 4; o < 32; o <<= 1) { wlo |= __shfl_xor(wlo, o); whi |= __shfl_xor(whi, o); }
    const unsigned long long wsel = (unsigned long long)__builtin_amdgcn_readfirstlane(wlo) | ((unsigned long long)__builtin_amdgcn_readfirstlane(whi) << 32);

    float* stash = PS + wid * 2048 + lane;
#pragma unroll
    for (int rg = 0; rg < 16; ++rg) { stash[rg * 64] = out0[rg]; stash[(16 + rg) * 64] = out1[rg]; }
    __syncthreads();
#define KV_LOAD_TO(kr, vr, KOFF, vtb, j) do { kr = *(const u32x4*)(zb + ((unsigned)(j) * (64u * LDZ * 2u) + zoff + (KOFF) * 2u)); vr = *(const u32x4*)((vtb) + ((unsigned)(j) * 128u + vtoff)); } while (0)
#define KV_LOAD(KOFF, vtb, j) KV_LOAD_TO(kreg, vreg, KOFF, vtb, j)
#define KV_LOAD_RING(i, KOFF, vtb, j) do { if ((i) & 1) KV_LOAD_TO(kregB, vregB, KOFF, vtb, j); else KV_LOAD_TO(kregA, vregA, KOFF, vtb, j); } while (0)
    {
        m = NEGF; l = 0.f; o0 = (f32x16){}; o1 = (f32x16){};
        const int j0 = qt >= 8 ? qt - 8 : 0, nj = qt - j0 + 1;
        KV_LOAD_TO(kregA, vregA, ZKW, vtwb, j0); KV_LOAD_TO(kregB, vregB, ZKW, vtwb, (nj > 1) ? j0 + 1 : j0);
        ST_STORE4(0, kregA, vregA); ST_STORE4(1, kregB, vregB);
        __syncthreads();
        const int nst = (nj + 1) >> 1;
        for (int st = 0; st < nst; ++st) {
            const int pb = (st & 1) * 2, ia = 2 * st, ib = ia + 1;
            KV_LOAD_TO(kregA, vregA, ZKW, vtwb, j0 + ((ia + 2 < nj) ? ia + 2 : ia)); KV_LOAD_TO(kregB, vregB, ZKW, vtwb, j0 + ((ia + 3 < nj) ? ia + 3 : ia));
            { const int ja_ = j0 + ia, jb_ = j0 + ib;
              const int loa = (ja_ == qt - 8) ? ti + 1 : 0, hia = (ja_ == qt) ? ti : 63, lob = (jb_ == qt - 8) ? ti + 1 : 0, hib = (jb_ == qt) ? ti : 63;
              if (ib < nj) attn_tile2(lds + AL_K4 + pb * 9216, lds + AL_V4 + pb * 9216, lds + AL_K4 + (pb + 1) * 9216, lds + AL_V4 + (pb + 1) * 9216, qr,
                                      (ja_ == qt - 8) || (ja_ == qt), loa, hia, true, (jb_ == qt - 8) || (jb_ == qt), lob, hib, true, m, l, o0, o1, lane);
              else attn_tile<2>(lds + AL_K4 + pb * 9216, lds + AL_V4 + pb * 9216, qr, (ja_ == qt - 8) || (ja_ == qt), loa, hia, true, m, l, 0.f, o0, o1, nullptr, lane); }
            if (ia + 2 < nj) { ST_STORE4(2 - pb, kregA, vregA); ST_STORE4(3 - pb, kregB, vregB); }
            LBAR();
        }
        const float lt = l + __shfl_xor(l, 32);
        const float sc = lt > 0.f ? g2 / lt : 0.f;
#pragma unroll
        for (int rg = 0; rg < 16; ++rg) { stash[rg * 64] += o0[rg] * sc; stash[(16 + rg) * 64] += o1[rg] * sc; }
    }
    {
        m = NEGF; l = 0.f; o0 = (f32x16){}; o1 = (f32x16){};
        const int nj = qt + 1;
        KV_LOAD_TO(kregA, vregA, ZKS, vtsb, 0); KV_LOAD_TO(kregB, vregB, ZKS, vtsb, (nj > 1) ? 1 : 0);
        ST_STORE4(0, kregA, vregA); ST_STORE4(1, kregB, vregB);
        __syncthreads();
        const int nst = (nj + 1) >> 1;
        for (int st = 0; st < nst; ++st) {
            const int pb = (st & 1) * 2, ja = 2 * st, jb = ja + 1;
            KV_LOAD_TO(kregA, vregA, ZKS, vtsb, (ja + 2 < nj) ? ja + 2 : ja); KV_LOAD_TO(kregB, vregB, ZKS, vtsb, (ja + 3 < nj) ? ja + 3 : ja);
#ifndef PROBE_SLC_SKIP
            { const bool ona = ((wsel >> ja) & 1ull) != 0ull, onb = jb < nj && ((wsel >> jb) & 1ull) != 0ull;
              if (ona && onb) attn_tile2(lds + AL_K4 + pb * 9216, lds + AL_V4 + pb * 9216, lds + AL_K4 + (pb + 1) * 9216, lds + AL_V4 + (pb + 1) * 9216, qr,
                                         ja == qt, 0, ti, ((mysel >> ja) & 1ull) != 0ull, jb == qt, 0, ti, ((mysel >> jb) & 1ull) != 0ull, m, l, o0, o1, lane);
              else if (ona) attn_tile<2>(lds + AL_K4 + pb * 9216, lds + AL_V4 + pb * 9216, qr, ja == qt, 0, ti, ((mysel >> ja) & 1ull) != 0ull, m, l, 0.f, o0, o1, nullptr, lane);
              else if (onb) attn_tile<2>(lds + AL_K4 + (pb + 1) * 9216, lds + AL_V4 + (pb + 1) * 9216, qr, jb == qt, 0, ti, ((mysel >> jb) & 1ull) != 0ull, m, l, 0.f, o0, o1, nullptr, lane); }
#endif
            if (ja + 2 < nj) { ST_STORE4(2 - pb, kregA, vregA); ST_STORE4(3 - pb, kregB, vregB); }
            LBAR();
        }
        const float lt = l + __shfl_xor(l, 32);
        const float sc = lt > 0.f ? g1 / lt : 0.f;
#pragma unroll
        for (int rg = 0; rg < 16; ++rg) { out0[rg] = stash[rg * 64] + o0[rg] * sc; out1[rg] = stash[(16 + rg) * 64] + o1[rg] * sc; }
    }
    unsigned char* orow = qrow;
#pragma unroll
    for (int rg = 0; rg < 4; ++rg) {
        u32x2 w0; w0.x = pk2(out0[4 * rg], out0[4 * rg + 1]); w0.y = pk2(out0[4 * rg + 2], out0[4 * rg + 3]);
        *(u32x2*)(orow + (8 * rg + 4 * hh) * 2) = w0;
        u32x2 w1; w1.x = pk2(out1[4 * rg], out1[4 * rg + 1]); w1.y = pk2(out1[4 * rg + 2], out1[4 * rg + 3]);
        *(u32x2*)(orow + (32 + 8 * rg + 4 * hh) * 2) = w1;
    }
#undef ST_STORE
#undef ST_STORE4
#undef LBAR
#undef ST_STORE_R
#undef RING_PUT
#undef RING_GET
#undef CMP_LOAD
#undef KV_LOAD
#undef KV_LOAD_TO
#undef KV_LOAD_RING
}

#define GAS __attribute__((address_space(1)))
#define LAS __attribute__((address_space(3)))
typedef GAS unsigned gu32;
typedef GAS unsigned long long gu64;
#define RLX_AGENT __ATOMIC_RELAXED, __HIP_MEMORY_SCOPE_AGENT
#define LDS_WAIT() asm volatile("s_waitcnt lgkmcnt(0)" ::: "memory")
#define VM_WAIT() asm volatile("s_waitcnt vmcnt(0)" ::: "memory")
__device__ __forceinline__ unsigned long long rt() { return __builtin_amdgcn_s_memrealtime(); }
#define XB_TMO      128
#define XB_XCNT(j)  (256  + 64 * (j))
#define XB_XSUB(j)  (1280 + 64 * (j))
#define XB_XGEN(j)  (2304 + 64 * (j))
#define XB_TOP      3328
#define XB_TOPGEN   3392
#define XCD_BAR_WORDS 3456
#define XB_SPIN_CAP (1u << 18)

__device__ __forceinline__ unsigned xb_ld(unsigned* p)              { return __hip_atomic_load(p, __ATOMIC_RELAXED, __HIP_MEMORY_SCOPE_AGENT); }
__device__ __forceinline__ unsigned xb_add(unsigned* p, unsigned v) { return __hip_atomic_fetch_add(p, v, __ATOMIC_RELAXED, __HIP_MEMORY_SCOPE_AGENT); }
__device__ __forceinline__ unsigned xb_xcc_id() { return (unsigned)__builtin_amdgcn_s_getreg((3 << 11) | 20) & 0xFu; }
#define XB_SPIN(cond, bar) do { unsigned _sp = 0; while (cond) { __builtin_amdgcn_s_sleep(1); \
    if ((++_sp & 255u) == 0u) { if (xb_ld(&(bar)[XB_TMO])) break; if (_sp > XB_SPIN_CAP) { atomicAdd(&(bar)[XB_TMO], 1u); break; } } } } while (0)

struct XcdBarrier {
    unsigned* bar; unsigned x;
    volatile LAS unsigned* st;
};

__device__ __forceinline__ XcdBarrier xcd_barrier_post(unsigned* bar, volatile LAS unsigned* st) {
    XcdBarrier b; b.bar = bar; b.x = xb_xcc_id(); b.st = st;
    if (threadIdx.x == 0) (void)xb_add(&bar[XB_XCNT(b.x)], 1u);
    return b;
}
__device__ __forceinline__ void xcd_barrier_complete(unsigned* bar, unsigned x, unsigned& nloc, unsigned& nx) {
    const unsigned G = gridDim.x * gridDim.y * gridDim.z;
    unsigned sum, cnt, mine, sp = 0u;
    for (;;) {
        sum = 0u; cnt = 0u; mine = 0u;
#pragma unroll
        for (unsigned j = 0; j < 16; ++j) { const unsigned c = xb_ld(&bar[XB_XCNT(j)]); sum += c; cnt += (c > 0u) ? 1u : 0u; mine = (j == x) ? c : mine; }
        if (sum == G) break;
        __builtin_amdgcn_s_sleep(1);
        if ((++sp & 255u) == 0u) { if (xb_ld(&bar[XB_TMO])) break; if (sp > XB_SPIN_CAP) { atomicAdd(&bar[XB_TMO], 1u); break; } }
    }
    nloc = mine > 0u ? mine : 1u; nx = cnt > 0u ? cnt : 1u;
}

__device__ __forceinline__ void xcd_barrier(const XcdBarrier& b) {
    asm volatile("s_waitcnt vmcnt(0)" ::: "memory");
    __syncthreads();
    if (threadIdx.x == 0) {
        unsigned* bar = b.bar;
        __builtin_amdgcn_s_waitcnt(0);
        unsigned nloc = b.st[0], nx = b.st[1];
        if (nloc == 0u) { xcd_barrier_complete(bar, b.x, nloc, nx); b.st[0] = nloc; b.st[1] = nx; }
        const unsigned old = xb_add(&bar[XB_XSUB(b.x)], 1u);
        const unsigned gen = old / nloc;
        if (old + 1u == (gen + 1u) * nloc) {
            __builtin_amdgcn_fence(__ATOMIC_RELEASE, "agent");
            asm volatile("s_waitcnt vmcnt(0)" ::: "memory");
            const unsigned og = xb_add(&bar[XB_TOP], 1u);
            const unsigned tg = og / nx;
            if (og + 1u == (tg + 1u) * nx) xb_add(&bar[XB_TOPGEN], 1u);
            else XB_SPIN(xb_ld(&bar[XB_TOPGEN]) == tg, bar);
            __builtin_amdgcn_fence(__ATOMIC_ACQUIRE, "agent");
            xb_add(&bar[XB_XGEN(b.x)], 1u);
            asm volatile("s_waitcnt vmcnt(0)" ::: "memory");
        } else {
            XB_SPIN(xb_ld(&bar[XB_XGEN(b.x)]) == gen, bar);
            __builtin_amdgcn_fence(__ATOMIC_ACQUIRE, "agent");
            asm volatile("s_waitcnt vmcnt(0)" ::: "memory");
        }
    }
    __syncthreads();
}

struct EpiResFinal {
    static constexpr bool PERM = false, AFTER_DRAIN = false;
    const bf16_t* XB; float* X; float* ssq; const float* w; XcdBarrier bar;
    __device__ __forceinline__ void operator()(f32x4 (&acc)[2][2][4][2], const pg8::Unit& u, int wr, int wc, int fr, int fq) const {
        const int row0 = u.pm * 256 + wr * 64 + fr;
        const int col0 = u.pn * 256 + wc * 32 + 4 * fq;
#pragma unroll
        for (int ai = 0; ai < 2; ++ai)
#pragma unroll
            for (int m = 0; m < 4; ++m) {
                const int row = row0 + ai * 128 + m * 16;
                float ss = 0.f;
                asm volatile("" ::: "memory");
#pragma unroll
                for (int bj = 0; bj < 2; ++bj)
#pragma unroll
                    for (int n = 0; n < 2; ++n) {
                        const size_t off = (size_t)row * DM + col0 + bj * 128 + n * 16;
                        const u32x2 xo = *(const u32x2*)(XB + off);
                        const f32x4 v = (f32x4){bflo(xo.x), bfhi(xo.x), bflo(xo.y), bfhi(xo.y)} + acc[ai][bj][m][n];
                        acc[ai][bj][m][n] = v;
                        ss += (v.x * v.x + v.y * v.y) + (v.z * v.z + v.w * v.w);
                    }
                ss += __shfl_xor(ss, 16); ss += __shfl_xor(ss, 32);
                if (fq == 0) ssq[(size_t)row * 16 + u.pn * 4 + wc] = ss;
            }
        xcd_barrier(bar);
#pragma unroll
        for (int ai = 0; ai < 2; ++ai)
#pragma unroll
            for (int m = 0; m < 4; ++m) {
                const int row = row0 + ai * 128 + m * 16;
                asm volatile("" ::: "memory");
                const float rstd = rstd_from_ssq(ssq + (size_t)row * 16);
#pragma unroll
                for (int bj = 0; bj < 2; ++bj)
#pragma unroll
                    for (int n = 0; n < 2; ++n) {
                        const int col = col0 + bj * 128 + n * 16;
                        const f32x4 wv = *(const f32x4*)(w + col);
                        *(f32x4*)(X + (size_t)row * DM + col) = acc[ai][bj][m][n] * rstd * wv;
                    }
            }
    }
};

__global__ void __launch_bounds__(NTHREADS, 2) nsa_fwd(Args a_unused) {
    extern __shared__ __attribute__((aligned(16))) unsigned char lds[];
    cg::grid_group grid = cg::this_grid();
    const int G0 = gridDim.x, bid0 = blockIdx.x;
    const int wave_s = __builtin_amdgcn_readfirstlane(threadIdx.x >> 6);
    PG8_LAS unsigned char* lds3 = (PG8_LAS unsigned char*)lds;
    volatile LAS unsigned* bst = (volatile LAS unsigned*)(lds3 + (LDS_BYTES - 64));
    if (threadIdx.x < 2) bst[threadIdx.x] = 0u;
    __syncthreads();
    XcdBarrier xbar;
    { const Args a = load_args(); xbar = xcd_barrier_post((unsigned*)(a.ws + WS_CTL), bst); }
    if (G0 == 0x7fffffff) grid.sync();
#define GRID_SYNC() xcd_barrier(xbar)
#define SIDS() int G = G0, bid = bid0; asm volatile("" : "+s"(G), "+s"(bid))
#define TIDS() SIDS(); const int tid = tid_now(wave_s), lane = tid & 63, wave = __builtin_amdgcn_readfirstlane(tid >> 6), gw = bid * 8 + wave, ngw = G * 8; (void)lane; (void)gw; (void)ngw
#define ZP(a) ((bf16_t*)((a).ws + WS_Z))
#define XBP(a) ((bf16_t*)((a).ws + WS_XB))
#define SSQP(a) ((float*)((a).ws + WS_SSQ))
#define WP(a) ((a).ws + WS_W)
#pragma unroll 1
    for (int l = 0; l < DEPTH; ++l) {
#pragma unroll 1
        for (int rep = 0; rep < REP_P0; ++rep)
        { TIDS(); const Args a = load_args(); phase_weights(a, l, lds, gw, ngw, wave, lane); }
        if (l == 0) { TIDS(); const Args a = load_args(); phase_x0(a, gw, ngw, lane); }
        GRID_SYNC();
#ifdef PROBE_SYNC
#pragma unroll 1
        for (int rep = 0; rep < PROBE_SYNC; ++rep) GRID_SYNC();
#endif
#ifdef PROBE_G1
#pragma unroll 1
        for (int rep = 0; rep < PROBE_G1; ++rep)
#endif
        {
            SIDS(); const Args a = load_args();
            pg8::Gemm gm{XBP(a), (const bf16_t*)(WP(a) + W_IN), TOK, NIN, DM, DM}; pg8::StaticOrder S; S.init(TOK, NIN, G, bid);
            fill_rtab(S, SSQP(a) + (size_t)(2 * l) * TOK * 16, (float*)(lds + RTAB_OFF), tid_now(wave_s));
            EpiIn E{ZP(a), (float*)(a.ws + WS_GN), (bf16_t*)(a.ws + WS_VT), (const float*)(lds + RTAB_OFF), 0};
            pg8::gemm_phase<EpiIn, pg8::StaticOrder, true, true>(lds3, gm, S, E, tid_now(wave_s));
        }
        GRID_SYNC();
#pragma unroll 1
        for (int rep = 0; rep < REP_P2; ++rep) {
        { TIDS(); const Args a = load_args(); for (int it = bid; it < 256; it += G) cmp_item(a, l, it, lds, tid); }
        { TIDS(); const Args a = load_args(); rnn_phase<1>(a, l, lds, tid, bid, G); }
        }
        GRID_SYNC();
#ifdef PROBE_R2
#pragma unroll 1
        for (int rep = 0; rep < PROBE_R2; ++rep)
#endif
        { TIDS(); const Args a = load_args(); rnn_phase<2>(a, l, lds, tid, bid, G); }
        {
            SIDS();
#pragma unroll 1
            for (int u = bid; u < 256; u += G) {
#pragma unroll 1
                for (int h2 = 0; h2 < 2; ++h2) {
                    const int bg = u & 7, s = u >> 3;
                    int b_ = bg >> 1, g_ = bg & 1, qt_ = h2 ? s : 63 - s;
                    asm volatile("" : "+s"(b_), "+s"(g_), "+s"(qt_));
                    const Args a = load_args();
                    attn_unit(a, b_, g_, qt_, lds, tid_now(wave_s));
                }
            }
        }
        GRID_SYNC();
        {
            SIDS(); const Args a = load_args();
            pg8::Gemm gm{ZP(a) + ZQ, (const bf16_t*)(WP(a) + W_UPA), TOK, DM, 512, LDZ}; pg8::StaticOrder S; S.init(TOK, DM, G, bid);
            EpiUp<0> E{ZP(a)};
            pg8::gemm_phase<EpiUp<0>, pg8::StaticOrder, true, true>(lds3, gm, S, E, tid_now(wave_s));
        }
        {
            SIDS(); const Args a = load_args();
            pg8::Gemm gm{ZP(a) + ZGR, (const bf16_t*)(WP(a) + W_UPR), TOK, DM, DM, LDZ}; pg8::StaticOrder S; S.init(TOK, DM, G, bid);
            EpiUp<1> E{ZP(a)};
            pg8::gemm_phase<EpiUp<1>, pg8::StaticOrder, true, true>(lds3, gm, S, E, tid_now(wave_s));
        }
        GRID_SYNC();
        {
            SIDS(); const Args a = load_args();
            pg8::Gemm gm{ZP(a) + ZXR, (const bf16_t*)(WP(a) + W_OUT), TOK, DM, DM, LDZ}; pg8::StaticOrder S; S.init(TOK, DM, G, bid);
            { EpiRes<false> E{nullptr, XBP(a), SSQP(a) + (size_t)(2 * l + 1) * TOK * 16};
                pg8::gemm_phase<EpiRes<false>, pg8::StaticOrder, true, true>(lds3, gm, S, E, tid_now(wave_s)); }
        }
        GRID_SYNC();
#ifdef PROBE_G6
#pragma unroll 1
        for (int rep = 0; rep < PROBE_G6; ++rep)
#endif
        {
            SIDS(); const Args a = load_args();
            pg8::Gemm gm{XBP(a), (const bf16_t*)(WP(a) + W_1), TOK, DFF, DM, DM}; pg8::StaticOrder S; S.init(TOK, DFF, G, bid);
            fill_rtab(S, SSQP(a) + (size_t)(2 * l + 1) * TOK * 16, (float*)(lds + RTAB_OFF), tid_now(wave_s));
            EpiMlpUp E{ZP(a), (const float*)(lds + RTAB_OFF), 0};
            pg8::gemm_phase<EpiMlpUp, pg8::StaticOrder, true, true>(lds3, gm, S, E, tid_now(wave_s));
        }
        GRID_SYNC();
        if (l + 1 < DEPTH) {
            SIDS(); const Args a = load_args();
            pg8::Gemm gm{ZP(a), (const bf16_t*)(WP(a) + W_2), TOK, DM, DFF, DFF}; pg8::StaticOrder S; S.init(TOK, DM, G, bid);
            EpiRes<false> E{nullptr, XBP(a), SSQP(a) + (size_t)(2 * l + 2) * TOK * 16};
            pg8::gemm_phase<EpiRes<false>, pg8::StaticOrder, true, true>(lds3, gm, S, E, tid_now(wave_s));
            GRID_SYNC();
        } else if (G0 == 256) {
            SIDS(); const Args a = load_args();
            pg8::Gemm gm{ZP(a), (const bf16_t*)(WP(a) + W_2), TOK, DM, DFF, DFF}; pg8::StaticOrder S; S.init(TOK, DM, G, bid);
            EpiResFinal E{XBP(a), a.out, SSQP(a) + (size_t)(2 * l + 2) * TOK * 16, a.in[22], xbar};
            pg8::gemm_phase<EpiResFinal, pg8::StaticOrder, true, true>(lds3, gm, S, E, tid_now(wave_s));
        } else {
            { SIDS(); const Args a = load_args();
              pg8::Gemm gm{ZP(a), (const bf16_t*)(WP(a) + W_2), TOK, DM, DFF, DFF}; pg8::StaticOrder S; S.init(TOK, DM, G, bid);
              EpiRes<false> E{nullptr, XBP(a), SSQP(a) + (size_t)(2 * l + 2) * TOK * 16};
              pg8::gemm_phase<EpiRes<false>, pg8::StaticOrder, true, true>(lds3, gm, S, E, tid_now(wave_s)); }
            GRID_SYNC();
            { TIDS(); const Args a = load_args(); phase_final(a, gw, ngw, lane); }
        }
    }
}

extern "C" void kernel_launch(void* const* d_in, const int* in_sizes, int n_in, void* d_out, int out_size, void* d_ws, size_t ws_size, hipStream_t stream) {
    static int grid = 0;
    if (grid == 0) {
        int dev = 0, cus = 0, per_cu = 0;
        hipGetDevice(&dev);
        hipDeviceGetAttribute(&cus, hipDeviceAttributeMultiprocessorCount, dev);
        hipFuncSetAttribute((const void*)nsa_fwd, hipFuncAttributeMaxDynamicSharedMemorySize, LDS_BYTES);
        hipOccupancyMaxActiveBlocksPerMultiprocessor(&per_cu, (const void*)nsa_fwd, NTHREADS, LDS_BYTES);
        if (per_cu < 1) per_cu = 1;
        grid = cus * per_cu;
        if (n_in != 23 || ws_size < WS_END) fprintf(stderr, "kernel_launch: unexpected n_in %d / ws %zu\n", n_in, ws_size);
        fprintf(stderr, "kernel_launch: grid %d (cus %d x %d)\n", grid, cus, per_cu);
    }
    (void)hipMemsetAsync((unsigned char*)d_ws + WS_CTL, 0, 16384, stream);
    Args a{};
    for (int i = 0; i < 23; ++i) a.in[i] = (const float*)d_in[i];
    a.out = (float*)d_out; a.ws = (unsigned char*)d_ws;
    void* args[] = {&a};
    hipError_t e = hipLaunchCooperativeKernel((const void*)nsa_fwd, dim3(grid), dim3(NTHREADS), args, LDS_BYTES, stream);
    if (e != hipSuccess) fprintf(stderr, "cooperative launch failed: %s (grid %d)\n", hipGetErrorString(e), grid);
}
```
